# Optimizing an MI355X kernel written in HIP

```python
import math
import jax, jax.numpy as jnp
from jax import lax
import numpy as np

D_MODEL = 1024
BATCH = 4
SEQ = 8192
DEPTH = 4

CTX_LEN = 256
GRID_W = 64
N_MIXERS = 4
MIXER_DIFF = 0
MIXER_FOURIER = 1
MIXER_NEIGHBOR = 2
MIXER_MLA = 3
Q_BLOCK = 128
ROPE_BASE = 10000.0
NORM_EPS = 1e-6
ADA_CHUNKS = 6
DA_HEAD_DIM = 64
DA_HEADS = D_MODEL // (2 * DA_HEAD_DIM)
FN_GROUPS = 4
NA_HEADS = 16
NA_HEAD_DIM = D_MODEL // NA_HEADS
NA_WIN_ROWS = 8
NA_WIN_COLS = 16
MLA_HEADS = 16
MLA_NOPE_DIM = 64
MLA_ROPE_DIM = 32
MLA_V_DIM = 64
MLA_Q_RANK = 768
MLA_KV_RANK = 256
N_EXPERTS = 16
EXPERT_DIM = 2048
EC_CAPACITY_FACTOR = 2

kernel_name = "hybrid_diffusion_trunk_diffattn_fnet_natten_mla_ecmoe"


def _n_layers_of(kind):
    return len(range(kind, DEPTH, N_MIXERS))


def _rmsnorm(x, g):
    xf = x.astype(jnp.float32)
    y = xf * lax.rsqrt(jnp.mean(xf * xf, axis=-1, keepdims=True) + NORM_EPS)
    return (y * g.astype(jnp.float32)).astype(x.dtype)


def _axial_rope_tables(n_tok, rot_dim):
    t = jnp.arange(n_tok)
    rows = (t // GRID_W).astype(jnp.float32)
    cols = (t % GRID_W).astype(jnp.float32)
    n_freq = rot_dim // 4
    inv_freq = ROPE_BASE ** (-jnp.arange(n_freq, dtype=jnp.float32) / n_freq)
    ang = jnp.concatenate([rows[:, None] * inv_freq, cols[:, None] * inv_freq], axis=-1)
    return jnp.cos(ang), jnp.sin(ang)


def _apply_rope(t, cos, sin):
    half = t.shape[-1] // 2
    t1 = t[..., :half].astype(jnp.float32)
    t2 = t[..., half:].astype(jnp.float32)
    return jnp.concatenate([t1 * cos - t2 * sin, t2 * cos + t1 * sin], axis=-1).astype(t.dtype)


def _to_blocks(t):
    *lead, n, d = t.shape
    return jnp.moveaxis(t.reshape(*lead, n // Q_BLOCK, Q_BLOCK, d), -3, 0)


def _from_blocks(o):
    o = jnp.moveaxis(o, 0, -3)
    *lead, nb, qb, d = o.shape
    return o.reshape(*lead, nb * qb, d)


def _merge_heads(o):
    b, h, n, d = o.shape
    return o.transpose(0, 2, 1, 3).reshape(b, n, h * d)


def _softmax_f32(s):
    return jax.nn.softmax(s.astype(jnp.float32), axis=-1)


def _dense_attention(q, k, v, scale):
    p = _softmax_f32(jnp.einsum('bhqd,bhkd->bhqk', q, k) * scale)
    return jnp.einsum('bhqk,bhkd->bhqd', p.astype(v.dtype), v)


def _diff_attention(h_ctx, h_lat, w_qkv, w_o, lam_q1, lam_k1, lam_q2, lam_k2, subln, lambda_init, with_ctx_out):
    scale = DA_HEAD_DIM ** -0.5

    def proj(h):
        b, n, _ = h.shape
        q, k, v = jnp.split(h @ w_qkv, 3, axis=-1)
        q = q.reshape(b, n, DA_HEADS, 2, DA_HEAD_DIM).transpose(3, 0, 2, 1, 4)
        k = k.reshape(b, n, DA_HEADS, 2, DA_HEAD_DIM).transpose(3, 0, 2, 1, 4)
        v = v.reshape(b, n, DA_HEADS, 2 * DA_HEAD_DIM).transpose(0, 2, 1, 3)
        return q, k, v

    q_c, k_c, v_c = proj(h_ctx)
    q_l, k_l, v_l = proj(h_lat)
    cos, sin = _axial_rope_tables(h_lat.shape[1], DA_HEAD_DIM)
    q_l = _apply_rope(q_l, cos, sin)
    k_l = _apply_rope(k_l, cos, sin)
    lam = (jnp.exp(jnp.sum(lam_q1 * lam_k1)) - jnp.exp(jnp.sum(lam_q2 * lam_k2))).astype(jnp.float32) + lambda_init

    def core(q, k, v):
        p = _softmax_f32(jnp.einsum('ibhqd,ibhkd->ibhqk', q, k) * scale)
        return jnp.einsum('bhqk,bhkd->bhqd', (p[0] - lam * p[1]).astype(v.dtype), v)

    def finish(o):
        return _merge_heads(_rmsnorm(o, subln) * (1.0 - lambda_init)) @ w_o

    k_all = jnp.concatenate([k_c, k_l], axis=3)
    v_all = jnp.concatenate([v_c, v_l], axis=2)
    o_l = _from_blocks(lax.map(lambda qb: core(qb, k_all, v_all), _to_blocks(q_l)))
    y_ctx = finish(core(q_c, k_c, v_c)) if with_ctx_out else None
    return y_ctx, finish(o_l)


def _fourier_group_mix(h, w_o):
    b, n, d = h.shape
    hg = h.astype(jnp.float32).reshape(b, n, FN_GROUPS, d // FN_GROUPS).transpose(0, 2, 1, 3)
    y = jnp.fft.fft2(hg, norm="ortho").real
    return y.transpose(0, 2, 1, 3).reshape(b, n, d).astype(h.dtype) @ w_o


def _fourier_mixer(h_ctx, h_lat, w_o, with_ctx_out):
    y_ctx = _fourier_group_mix(h_ctx, w_o) if with_ctx_out else None
    return y_ctx, _fourier_group_mix(h_lat, w_o)


def _neighborhood_attention(h_ctx, h_lat, w_qkv, w_o, rpb, with_ctx_out):
    b, n, _ = h_lat.shape
    rows = n // GRID_W
    kr = min(NA_WIN_ROWS, rows)
    scale = NA_HEAD_DIM ** -0.5

    def proj(h):
        bh, nh, _ = h.shape
        heads = lambda t: t.reshape(bh, nh, NA_HEADS, NA_HEAD_DIM).transpose(0, 2, 1, 3)
        q, k, v = jnp.split(h @ w_qkv, 3, axis=-1)
        return heads(q), heads(k), heads(v)

    q_c, k_c, v_c = proj(h_ctx)
    q_l, k_l, v_l = proj(h_lat)
    grid = lambda t: t.reshape(b, NA_HEADS, rows, GRID_W, NA_HEAD_DIM)
    k_g, v_g = grid(k_l), grid(v_l)
    q_rows = jnp.moveaxis(grid(q_l), 2, 0)
    cols = np.arange(GRID_W)
    col_start = np.clip(cols - NA_WIN_COLS // 2, 0, GRID_W - NA_WIN_COLS)
    col_idx = col_start[:, None] + np.arange(NA_WIN_COLS)
    col_bias_idx = col_idx - cols[:, None] + NA_WIN_COLS - 1
    rpb_cols = rpb[:, :, col_bias_idx]

    def row_fn(args):
        r, q = args
        r0 = jnp.clip(r - kr // 2, 0, rows - kr)
        kb = lax.dynamic_slice_in_dim(k_g, r0, kr, axis=2)[:, :, :, col_idx]
        vb = lax.dynamic_slice_in_dim(v_g, r0, kr, axis=2)[:, :, :, col_idx]
        bias = rpb_cols[:, r0 + jnp.arange(kr) - r + NA_WIN_ROWS - 1].transpose(0, 2, 1, 3)
        s_win = jnp.einsum('bhqd,bhrqjd->bhqrj', q, kb).astype(jnp.float32) * scale + bias.astype(jnp.float32)[None]
        s_ctx = jnp.einsum('bhqd,bhkd->bhqk', q, k_c).astype(jnp.float32) * scale
        p = _softmax_f32(jnp.concatenate([s_win.reshape(b, NA_HEADS, GRID_W, kr * NA_WIN_COLS), s_ctx], axis=-1))
        p = p.astype(v_c.dtype)
        p_win = p[..., :kr * NA_WIN_COLS].reshape(b, NA_HEADS, GRID_W, kr, NA_WIN_COLS)
        p_ctx = p[..., kr * NA_WIN_COLS:]
        return jnp.einsum('bhqrj,bhrqjd->bhqd', p_win, vb) + jnp.einsum('bhqk,bhkd->bhqd', p_ctx, v_c)

    o_rows = lax.map(row_fn, (jnp.arange(rows), q_rows))
    o_l = jnp.moveaxis(o_rows, 0, 2).reshape(b, NA_HEADS, n, NA_HEAD_DIM)
    y_ctx = _merge_heads(_dense_attention(q_c, k_c, v_c, scale)) @ w_o if with_ctx_out else None
    return y_ctx, _merge_heads(o_l) @ w_o


def _mla(h_ctx, h_lat, w_dq, q_norm, w_uq, w_dkv, kv_norm, w_uk, w_uv, w_o, with_ctx_out):
    scale = (MLA_NOPE_DIM + MLA_ROPE_DIM) ** -0.5

    def proj(h):
        b, n, _ = h.shape
        q = (_rmsnorm(h @ w_dq, q_norm) @ w_uq).reshape(b, n, MLA_HEADS, MLA_NOPE_DIM + MLA_ROPE_DIM).transpose(0, 2, 1, 3)
        ckv = h @ w_dkv
        c_kv = _rmsnorm(ckv[..., :MLA_KV_RANK], kv_norm)
        k_rope = ckv[..., MLA_KV_RANK:]
        k_nope = (c_kv @ w_uk).reshape(b, n, MLA_HEADS, MLA_NOPE_DIM).transpose(0, 2, 1, 3)
        v = (c_kv @ w_uv).reshape(b, n, MLA_HEADS, MLA_V_DIM).transpose(0, 2, 1, 3)
        return q[..., :MLA_NOPE_DIM], q[..., MLA_NOPE_DIM:], k_nope, k_rope, v

    qn_c, qr_c, kn_c, kr_c, v_c = proj(h_ctx)
    qn_l, qr_l, kn_l, kr_l, v_l = proj(h_lat)
    cos, sin = _axial_rope_tables(h_lat.shape[1], MLA_ROPE_DIM)
    qr_l = _apply_rope(qr_l, cos, sin)
    kr_l = _apply_rope(kr_l, cos, sin)

    def core(qn, qr, kn, kr, v):
        s = jnp.einsum('bhqd,bhkd->bhqk', qn, kn) + jnp.einsum('bhqd,bkd->bhqk', qr, kr)
        p = _softmax_f32(s * scale)
        return jnp.einsum('bhqk,bhkd->bhqd', p.astype(v.dtype), v)

    kn_all = jnp.concatenate([kn_c, kn_l], axis=2)
    kr_all = jnp.concatenate([kr_c, kr_l], axis=1)
    v_all = jnp.concatenate([v_c, v_l], axis=2)
    o_l = _from_blocks(lax.map(lambda qs: core(qs[0], qs[1], kn_all, kr_all, v_all), (_to_blocks(qn_l), _to_blocks(qr_l))))
    y_ctx = _merge_heads(core(qn_c, qr_c, kn_c, kr_c, v_c)) @ w_o if with_ctx_out else None
    return y_ctx, _merge_heads(o_l) @ w_o


def _expert_choice_moe(h, w_router, w_gate, w_up, w_down):
    b, n, d = h.shape
    cap = EC_CAPACITY_FACTOR * n // N_EXPERTS
    aff = jax.nn.softmax((h @ w_router).astype(jnp.float32), axis=-1)
    gate, idx = lax.top_k(jnp.swapaxes(aff, 1, 2), cap)
    xs = jax.vmap(lambda hb, ib: hb[ib])(h, idx)
    a = jnp.einsum('becd,edf->becf', xs, w_gate)
    u = jnp.einsum('becd,edf->becf', xs, w_up)
    y = jnp.einsum('becf,efd->becd', jax.nn.silu(a) * u, w_down) * gate[..., None].astype(h.dtype)
    return jax.vmap(lambda ib, yb: jnp.zeros((n, d), yb.dtype).at[ib.reshape(-1)].add(yb.reshape(-1, d)))(idx, y)


def setup_inputs(seed: int = 0) -> dict:
    key = jax.random.key(seed)
    keys = iter(jax.random.split(key, 64))
    f32 = jnp.float32

    def normal(shape, std):
        return std * jax.random.normal(next(keys), shape, f32)

    def lin(shape, scale=1.0):
        return normal(shape, scale * shape[-2] ** -0.5)

    def gain(shape):
        return 1.0 + normal(shape, 0.05)

    d = D_MODEL
    n_a, n_b, n_c, n_d = (_n_layers_of(k) for k in range(N_MIXERS))
    return {
        "x": normal((BATCH, SEQ, d), 1.0),
        "c": normal((BATCH, d), 1.0),
        "ctx": normal((BATCH, CTX_LEN, d), 1.0),
        "c_ctx": normal((d,), 1.0),
        "ada_w": lin((DEPTH, d, ADA_CHUNKS * d), 0.5),
        "ada_b": normal((DEPTH, ADA_CHUNKS * d), 0.02),
        "norm_mix": gain((DEPTH, d)),
        "norm_ffn": gain((DEPTH, d)),
        "norm_final": gain((d,)),
        "da_w_qkv": lin((n_a, d, 3 * d)),
        "da_w_o": lin((n_a, d, d)),
        "da_lambda_q1": normal((n_a, DA_HEAD_DIM), 0.1),
        "da_lambda_k1": normal((n_a, DA_HEAD_DIM), 0.1),
        "da_lambda_q2": normal((n_a, DA_HEAD_DIM), 0.1),
        "da_lambda_k2": normal((n_a, DA_HEAD_DIM), 0.1),
        "da_subln": gain((n_a, 2 * DA_HEAD_DIM)),
        "fn_w_o": lin((n_b, d, d)),
        "na_w_qkv": lin((n_c, d, 3 * d)),
        "na_w_o": lin((n_c, d, d)),
        "na_rpb": normal((n_c, NA_HEADS, 2 * NA_WIN_ROWS - 1, 2 * NA_WIN_COLS - 1), 0.1),
        "mla_w_dq": lin((n_d, d, MLA_Q_RANK)),
        "mla_q_norm": gain((n_d, MLA_Q_RANK)),
        "mla_w_uq": lin((n_d, MLA_Q_RANK, MLA_HEADS * (MLA_NOPE_DIM + MLA_ROPE_DIM))),
        "mla_w_dkv": lin((n_d, d, MLA_KV_RANK + MLA_ROPE_DIM)),
        "mla_kv_norm": gain((n_d, MLA_KV_RANK)),
        "mla_w_uk": lin((n_d, MLA_KV_RANK, MLA_HEADS * MLA_NOPE_DIM)),
        "mla_w_uv": lin((n_d, MLA_KV_RANK, MLA_HEADS * MLA_V_DIM)),
        "mla_w_o": lin((n_d, MLA_HEADS * MLA_V_DIM, d)),
        "moe_w_router": lin((DEPTH, d, N_EXPERTS)),
        "moe_w_gate": lin((DEPTH, N_EXPERTS, d, EXPERT_DIM)),
        "moe_w_up": lin((DEPTH, N_EXPERTS, d, EXPERT_DIM)),
        "moe_w_down": lin((DEPTH, N_EXPERTS, EXPERT_DIM, d)),
    }


def reference(x, c, ctx, c_ctx, ada_w, ada_b, norm_mix, norm_ffn, norm_final,
              da_w_qkv, da_w_o, da_lambda_q1, da_lambda_k1, da_lambda_q2, da_lambda_k2, da_subln,
              fn_w_o, na_w_qkv, na_w_o, na_rpb,
              mla_w_dq, mla_q_norm, mla_w_uq, mla_w_dkv, mla_kv_norm, mla_w_uk, mla_w_uv, mla_w_o,
              moe_w_router, moe_w_gate, moe_w_up, moe_w_down):
    for i in range(DEPTH):
        kind, j = i % N_MIXERS, i // N_MIXERS
        keep_ctx = i < DEPTH - 1
        mod = jax.nn.silu(c) @ ada_w[i] + ada_b[i]
        mod_c = jax.nn.silu(c_ctx) @ ada_w[i] + ada_b[i]
        sh1, sc1, g1, sh2, sc2, g2 = jnp.split(mod[:, None, :], ADA_CHUNKS, axis=-1)
        csh1, csc1, cg1, csh2, csc2, cg2 = jnp.split(mod_c, ADA_CHUNKS, axis=-1)
        h_lat = _rmsnorm(x, norm_mix[i]) * (1.0 + sc1) + sh1
        h_ctx = _rmsnorm(ctx, norm_mix[i]) * (1.0 + csc1) + csh1
        if kind == MIXER_DIFF:
            lambda_init = 0.8 - 0.6 * math.exp(-0.3 * i)
            y_ctx, y_lat = _diff_attention(h_ctx, h_lat, da_w_qkv[j], da_w_o[j], da_lambda_q1[j], da_lambda_k1[j],
                                           da_lambda_q2[j], da_lambda_k2[j], da_subln[j], lambda_init, keep_ctx)
        elif kind == MIXER_FOURIER:
            y_ctx, y_lat = _fourier_mixer(h_ctx, h_lat, fn_w_o[j], keep_ctx)
        elif kind == MIXER_NEIGHBOR:
            y_ctx, y_lat = _neighborhood_attention(h_ctx, h_lat, na_w_qkv[j], na_w_o[j], na_rpb[j], keep_ctx)
        else:
            y_ctx, y_lat = _mla(h_ctx, h_lat, mla_w_dq[j], mla_q_norm[j], mla_w_uq[j], mla_w_dkv[j], mla_kv_norm[j],
                                mla_w_uk[j], mla_w_uv[j], mla_w_o[j], keep_ctx)
        x = x + g1 * y_lat
        h_lat = _rmsnorm(x, norm_ffn[i]) * (1.0 + sc2) + sh2
        x = x + g2 * _expert_choice_moe(h_lat, moe_w_router[i], moe_w_gate[i], moe_w_up[i], moe_w_down[i])
        if keep_ctx:
            ctx = ctx + cg1 * y_ctx
            h_ctx = _rmsnorm(ctx, norm_ffn[i]) * (1.0 + csc2) + csh2
            ctx = ctx + cg2 * _expert_choice_moe(h_ctx, moe_w_router[i], moe_w_gate[i], moe_w_up[i], moe_w_down[i])
    return _rmsnorm(x, norm_final)
```

```cpp
#include <hip/hip_runtime.h>
#include <cstdio>
#include <cstdint>

#ifndef MK_ONE_LAUNCH
#define MK_ONE_LAUNCH 1
#endif
#ifndef MK_NSTAGE
#define MK_NSTAGE 99
#endif

#define GAS __attribute__((address_space(1)))
#define LAS __attribute__((address_space(3)))
typedef unsigned short bf16_t;
typedef unsigned v4u __attribute__((ext_vector_type(4)));
typedef unsigned v2u __attribute__((ext_vector_type(2)));
typedef float f32x4 __attribute__((ext_vector_type(4)));
typedef float f32x2 __attribute__((ext_vector_type(2)));
typedef short bf16x8 __attribute__((ext_vector_type(8)));
typedef short s16x4 __attribute__((ext_vector_type(4)));
typedef float f32x16 __attribute__((ext_vector_type(16)));
typedef GAS unsigned gu32;
#define RLX_AGENT __ATOMIC_RELAXED, __HIP_MEMORY_SCOPE_AGENT
#define LDS_WAIT() asm volatile("s_waitcnt lgkmcnt(0)" ::: "memory")
#define VM_WAIT() asm volatile("s_waitcnt vmcnt(0)" ::: "memory")

constexpr int DM = 1024, NB = 4, SEQ = 8192, CTXL = 256, NTB = SEQ + CTXL  , MALL = NB * NTB  ;
constexpr int DEPTH = 4, GRIDW = 64, NEXP = 16, EDIM = 2048;
constexpr int CAP_L = 1024, CAP_C = 32, SLOTS_E = 4352  , NSLOT = NEXP * SLOTS_E  ;
constexpr float NORM_EPS = 1e-6f;
constexpr float LOG2E = 1.4426950408889634f;

__device__ __forceinline__ unsigned f2bf(float f) { unsigned u = __builtin_bit_cast(unsigned, f); return (u + 0x7fffu + ((u >> 16) & 1u)) >> 16; }
__device__ __forceinline__ unsigned pk2(float lo, float hi) { return f2bf(lo) | (f2bf(hi) << 16); }
__device__ __forceinline__ float bf2f(unsigned short h) { return __builtin_bit_cast(float, (unsigned)h << 16); }
__device__ __forceinline__ unsigned cvt_pk_bf16(float lo, float hi) { unsigned r; asm volatile("v_cvt_pk_bf16_f32 %0, %1, %2" : "=v"(r) : "v"(lo), "v"(hi)); return r; }
__device__ __forceinline__ f32x4 bfx4(v2u w) { return (f32x4){__builtin_bit_cast(float, w.x << 16), __builtin_bit_cast(float, w.x & 0xffff0000u), __builtin_bit_cast(float, w.y << 16), __builtin_bit_cast(float, w.y & 0xffff0000u)}; }
#ifndef MK_XBF16
#define MK_XBF16 1
#endif
#if MK_XBF16
typedef bf16_t xres_t; typedef v2u xraw_t;
__device__ __forceinline__ f32x4 xexp(xraw_t w) { return (f32x4){__builtin_bit_cast(float, w.x << 16), __builtin_bit_cast(float, w.x & 0xffff0000u), __builtin_bit_cast(float, w.y << 16), __builtin_bit_cast(float, w.y & 0xffff0000u)}; }
__device__ __forceinline__ xraw_t xpack(f32x4 v) { xraw_t w; w.x = cvt_pk_bf16(v[0], v[1]); w.y = cvt_pk_bf16(v[2], v[3]); return w; }
#else
typedef float xres_t; typedef f32x4 xraw_t;
__device__ __forceinline__ f32x4 xexp(xraw_t w) { return w; }
__device__ __forceinline__ xraw_t xpack(f32x4 v) { return v; }
#endif
__device__ __forceinline__ xraw_t ldxr(const xres_t* p) { return *(const xraw_t*)p; }
__device__ __forceinline__ f32x4 ldx4(const xres_t* p) { return xexp(*(const xraw_t*)p); }
__device__ __forceinline__ void stx4(xres_t* p, f32x4 v) { *(xraw_t*)p = xpack(v); }
#if MK_XBF16
__device__ __forceinline__ void ldx8(const xres_t* p, f32x4& a, f32x4& b) { const v4u w = *(const v4u*)p; a = xexp((v2u){w.x, w.y}); b = xexp((v2u){w.z, w.w}); }
__device__ __forceinline__ void stx8(xres_t* p, f32x4 a, f32x4 b) { const v2u lo = xpack(a), hi = xpack(b); *(v4u*)p = (v4u){lo.x, lo.y, hi.x, hi.y}; }
#else
__device__ __forceinline__ void ldx8(const xres_t* p, f32x4& a, f32x4& b) { a = *(const f32x4*)p; b = *(const f32x4*)(p + 4); }
__device__ __forceinline__ void stx8(xres_t* p, f32x4 a, f32x4 b) { *(f32x4*)p = a; *(f32x4*)(p + 4) = b; }
#endif
__device__ __forceinline__ float wave_sum(float v) {
#pragma unroll
    for (int o = 1; o < 64; o <<= 1) v += __shfl_xor(v, o);
    return v;
}
__device__ __forceinline__ int midx_of_row(int row) { const int b = row / NTB; return (row - b * NTB) < CTXL ? 4 : b; }

constexpr size_t MiB = 1u << 20;
constexpr size_t WS_CTL = 0, CTL_ZERO_BYTES = 2 * MiB;
constexpr int CW_BAR = 4096;
constexpr int CW_KMAX = 24576;
constexpr int CW_Q = 16384;
constexpr int CONV_ITEMS = 16 * 3 * 1024;
constexpr size_t CTL_MOD_OFF = 512 * 1024;
constexpr float MOD_SC = 68719476736.f, MOD_ISC = 1.f / 68719476736.f;
constexpr size_t WS_TAB = 2 * MiB;
constexpr size_t WS_W = 3 * MiB;
constexpr size_t W_DA_QKV = WS_W, W_DA_O = W_DA_QKV + 6 * MiB, W_FN = W_DA_O + 2 * MiB, W_NA_QKV = W_FN + 4 * MiB, W_NA_O = W_NA_QKV + 6 * MiB,
                 W_MLA_DQKV = W_NA_O + 2 * MiB, W_MLA_UQ = W_MLA_DQKV + 3 * MiB, W_MLA_UKV = W_MLA_UQ + 3 * MiB, W_MLA_O = W_MLA_UKV + 1 * MiB, WS_W_END = W_MLA_O + 2 * MiB;
static_assert(WS_W_END <= 35 * MiB && CTL_MOD_OFF + 4 * 5 * 6144 * 8 <= CTL_ZERO_BYTES, "small weights / ctl");
constexpr size_t WS_WGU = 35 * MiB;
constexpr size_t WS_WDN = WS_WGU + 512 * MiB;
constexpr size_t WS_X = WS_WDN + 256 * MiB;
constexpr size_t WS_H = WS_X + 132 * MiB;
constexpr size_t WS_AFF = WS_H + 66 * MiB;
constexpr size_t WS_IDX = WS_AFF + 3 * MiB;
constexpr size_t WS_GATE = WS_IDX + 1 * MiB;
constexpr size_t WS_TOKSLOT = WS_GATE + 1 * MiB;
constexpr size_t WS_Y = WS_TOKSLOT + 3 * MiB;
constexpr size_t WS_YC = WS_Y + 136 * MiB;
constexpr size_t WS_S = WS_YC + 32 * MiB;
constexpr size_t WS_S_BYTES = 640 * MiB;
constexpr size_t WS_END = WS_S + WS_S_BYTES;
constexpr size_t S_Q = 0, S_K = 66 * MiB, S_V = 132 * MiB, S_O = 198 * MiB, S_OTMP = 264 * MiB;
constexpr size_t S_TT = 0, S_TTC = 128 * MiB, S_G2 = 132 * MiB, S_W2 = 260 * MiB, S_W1B = 261 * MiB, S_DFTC = 262 * MiB;
constexpr size_t S_DQ = 0, S_QN = 166 * MiB, S_CKVN = 216 * MiB, S_KR = 233 * MiB, S_MQ = 236 * MiB, S_MKN = 336 * MiB, S_MV = 402 * MiB, S_MO = 468 * MiB;
constexpr size_t S_ACT = 0;
static_assert(S_MO + 66 * MiB <= WS_S_BYTES && S_DFTC + 1 * MiB <= WS_S_BYTES && S_OTMP + 132 * MiB <= WS_S_BYTES, "scratch map");
constexpr int TAB_COS64 = 0, TAB_SIN64 = 192 * 16, TAB_COS32 = 2 * 192 * 16, TAB_SIN32 = TAB_COS32 + 192 * 8, TAB_LAM = TAB_SIN32 + 192 * 8;

typedef long long i64;
__device__ __forceinline__ f32x4 ldmod4(const i64* p) { typedef i64 i64x2 __attribute__((ext_vector_type(2))); const i64x2 a = *(const i64x2*)p, b = *(const i64x2*)(p + 2);
    return (f32x4){(float)a.x * MOD_ISC, (float)a.y * MOD_ISC, (float)b.x * MOD_ISC, (float)b.y * MOD_ISC}; }
constexpr int RING_OFF = 0, RING_BYTES = 131072;
constexpr int LDSCTL_OFF = RING_BYTES, MISC_OFF = LDSCTL_OFF + 320;
constexpr int LDS_BYTES = 147456;
constexpr int NWAVES = 8, NTHR = 512;

#define XB_TMO      128
#define XB_XCNT(j)  (256  + 64 * (j))
#define XB_XSUB(j)  (1280 + 64 * (j))
#define XB_XGEN(j)  (2304 + 64 * (j))
#define XB_TOP      3328
#define XB_TOPGEN   3392
#define XCD_BAR_WORDS 3456
#define XB_SPIN_CAP (1u << 18)

__device__ __forceinline__ unsigned xb_ld(unsigned* p)              { return __hip_atomic_load(p, __ATOMIC_RELAXED, __HIP_MEMORY_SCOPE_AGENT); }
__device__ __forceinline__ unsigned xb_add(unsigned* p, unsigned v) { return __hip_atomic_fetch_add(p, v, __ATOMIC_RELAXED, __HIP_MEMORY_SCOPE_AGENT); }
__device__ __forceinline__ unsigned xb_xcc_id() { return (unsigned)__builtin_amdgcn_s_getreg((3 << 11) | 20) & 0xFu; }
#define XB_SPIN(cond, bar) do { unsigned _sp = 0; while (cond) { __builtin_amdgcn_s_sleep(1); \
    if ((++_sp & 255u) == 0u) { if (xb_ld(&(bar)[XB_TMO])) break; if (_sp > XB_SPIN_CAP) { atomicAdd(&(bar)[XB_TMO], 1u); break; } } } } while (0)

struct XcdBarrier {
    unsigned* bar; unsigned x;
    volatile LAS unsigned* st;
};

__device__ __forceinline__ XcdBarrier xcd_barrier_post(unsigned* bar, volatile LAS unsigned* st) {
    XcdBarrier b; b.bar = bar; b.x = xb_xcc_id(); b.st = st;
    if (threadIdx.x == 0) (void)xb_add(&bar[XB_XCNT(b.x)], 1u);
    return b;
}
__device__ __forceinline__ void xcd_barrier_complete(unsigned* bar, unsigned x, unsigned& nloc, unsigned& nx) {
    const unsigned G = gridDim.x * gridDim.y * gridDim.z;
    unsigned sum, cnt, mine, sp = 0u;
    for (;;) {
        sum = 0u; cnt = 0u; mine = 0u;
#pragma unroll
        for (unsigned j = 0; j < 16; ++j) { const unsigned c = xb_ld(&bar[XB_XCNT(j)]); sum += c; cnt += (c > 0u) ? 1u : 0u; mine = (j == x) ? c : mine; }
        if (sum == G) break;
        __builtin_amdgcn_s_sleep(1);
        if ((++sp & 255u) == 0u) { if (xb_ld(&bar[XB_TMO])) break; if (sp > XB_SPIN_CAP) { atomicAdd(&bar[XB_TMO], 1u); break; } }
    }
    nloc = mine > 0u ? mine : 1u; nx = cnt > 0u ? cnt : 1u;
}

__device__ __forceinline__ void xcd_barrier(const XcdBarrier& b) {
    asm volatile("s_waitcnt vmcnt(0)" ::: "memory");
    __syncthreads();
    if (threadIdx.x == 0) {
        unsigned* bar = b.bar;
        __builtin_amdgcn_s_waitcnt(0);
        unsigned nloc = b.st[0], nx = b.st[1];
        if (nloc == 0u) { xcd_barrier_complete(bar, b.x, nloc, nx); b.st[0] = nloc; b.st[1] = nx; }
        const unsigned old = xb_add(&bar[XB_XSUB(b.x)], 1u);
        const unsigned gen = old / nloc;
        if (old + 1u == (gen + 1u) * nloc) {
            __builtin_amdgcn_fence(__ATOMIC_RELEASE, "agent");
            asm volatile("s_waitcnt vmcnt(0)" ::: "memory");
            const unsigned og = xb_add(&bar[XB_TOP], 1u);
            const unsigned tg = og / nx;
            if (og + 1u == (tg + 1u) * nx) xb_add(&bar[XB_TOPGEN], 1u);
            else XB_SPIN(xb_ld(&bar[XB_TOPGEN]) == tg, bar);
            __builtin_amdgcn_fence(__ATOMIC_ACQUIRE, "agent");
            xb_add(&bar[XB_XGEN(b.x)], 1u);
            asm volatile("s_waitcnt vmcnt(0)" ::: "memory");
        } else {
            XB_SPIN(xb_ld(&bar[XB_XGEN(b.x)]) == gen, bar);
            __builtin_amdgcn_fence(__ATOMIC_ACQUIRE, "agent");
            asm volatile("s_waitcnt vmcnt(0)" ::: "memory");
        }
    }
    __syncthreads();
}

namespace pg8 {
#define PG8_LAS __attribute__((address_space(3)))
constexpr int BM = 256, BK = 64, HALF = 128, HTB = HALF * BK * 2  , STAGE_BYTES = 8 * HTB, NXCD = 8, WGM = 8;

__host__ __device__ __forceinline__ int lds_byte(int r, int c) { const int st = (r >> 4) * 2 + (c >> 5), rr = r & 15, cc = c & 31, ob = rr * 64 + cc * 2; return st * 1024 + (ob ^ (((ob >> 9) & 1) << 5)); }
__host__ __device__ __forceinline__ void stage_rc(int b, int& R, int& C) { const int st = b / 1024, sb = b % 1024, swz = sb ^ (((sb >> 9) & 1) << 5); R = (st >> 1) * 16 + swz / 64; C = (st & 1) * 32 + (swz % 64) / 2; }
__host__ __device__ __forceinline__ int perm32(int rho) { const int n = rho >> 4, i = rho & 15; return 8 * (i >> 2) + 4 * n + (i & 3); }

struct Unit { int pm, pn, z; };
struct Gemm { const bf16_t* A; const bf16_t* Bt; int lda, ldb, K; long sAz, sBz; const int* gidx; int gz; };

struct Order {
    int nM, nN, nZ, nwg, G, c;
    __device__ void init(int nM_, int nN_, int nZ_, int G_, int c_) { nM = nM_; nN = nN_; nZ = nZ_; nwg = nM_ * nN_ * nZ_; G = G_; c = c_; }
    __device__ bool next(int i, Unit& u) const {
        const long L = (long)i * G + c; if (L >= nwg) return false;
        int wgid = (int)L; { const int q = nwg / NXCD, r = nwg % NXCD, xcd = wgid % NXCD, off = wgid / NXCD; wgid = (xcd < r ? xcd * (q + 1) : r * (q + 1) + (xcd - r) * q) + off; }
        const int nMt = nM * nZ, nig = WGM * nN, gid = wgid / nig, fm = gid * WGM, gsz = (nMt - fm) < WGM ? (nMt - fm) : WGM;
        const int pmt = fm + ((wgid % nig) % gsz); u.pn = (wgid % nig) / gsz; u.z = pmt / nM; u.pm = pmt - u.z * nM; return true;
    }
};

template <class Epi, bool GATHER, int BMODE = 0, bool ALIGN_EPI = true>
__device__ __forceinline__ void gemm_phase(PG8_LAS unsigned char* lds, const Gemm g, const Order& S, const Epi& E) {
    const int tid = threadIdx.x, wid = __builtin_amdgcn_readfirstlane(tid >> 6), lane = tid & 63, wr = wid >> 2, wc = wid & 3, fr = lane & 15, fq = lane >> 4;
    const int K = g.K, nt = K / BK;
    int Rr[2], Cc[2];
    unsigned aof0[2], aof1[2], naof0[2], naof1[2], bof0[2], bofN[2], bofP[2], nbof[2];
#pragma unroll
    for (int i = 0; i < 2; ++i) { int R, C; stage_rc(tid * 16 + i * 8192, R, C); Rr[i] = R; Cc[i] = C; const int Rb = Epi::PERM ? ((R & ~31) + perm32(R & 31)) : R;
        aof0[i] = (unsigned)(R * g.lda + C) * 2u; aof1[i] = aof0[i]; naof0[i] = aof0[i]; naof1[i] = aof0[i];
        bof0[i] = (unsigned)(Rb * g.ldb + C) * 2u; bofN[i] = bof0[i]; bofP[i] = (unsigned)(64 * Rb * g.ldb + C) * 2u; nbof[i] = bof0[i]; }
    const size_t kstep = (size_t)(BK * 2);
    const size_t hsA = GATHER ? (size_t)0 : (size_t)HALF * g.lda * 2, hsB = (size_t)HALF * g.ldb * 2;
    const unsigned ldsw = (unsigned)wid * 1024u;
    const int aoff = lds_byte(wr * 64 + fr, fq * 8), boff = lds_byte(wc * 32 + fr, fq * 8);
#define PG8_SA(b, h) (((b) * 2 + (h)) * HTB)
#define PG8_SB(b, h) ((4 + (b) * 2 + (h)) * HTB)
#define PG8_STAGE(bufoff, gbase, o0, o1) do { \
        __builtin_amdgcn_global_load_lds((const unsigned*)((const char*)(gbase) + (o0)), (PG8_LAS unsigned*)(lds + (bufoff) + ldsw), 16, 0, 0); \
        __builtin_amdgcn_global_load_lds((const unsigned*)((const char*)(gbase) + (o1)), (PG8_LAS unsigned*)(lds + (bufoff) + ldsw + 8192), 16, 0, 0); } while (0)
#define PG8_LDA(dst, b, h) do { _Pragma("unroll") for (int m = 0; m < 4; ++m) _Pragma("unroll") for (int k = 0; k < 2; ++k) dst[m][k] = *(const PG8_LAS bf16x8*)(lds + PG8_SA(b, h) + aoff + m * 2048 + k * 1024); } while (0)
#define PG8_LDB(dst, b, h) do { _Pragma("unroll") for (int n = 0; n < 2; ++n) _Pragma("unroll") for (int k = 0; k < 2; ++k) dst[n][k] = *(const PG8_LAS bf16x8*)(lds + PG8_SB(b, h) + boff + n * 2048 + k * 1024); } while (0)
#define PG8_MMA(ai, bj, At, Bt) do { __builtin_amdgcn_s_setprio(1); _Pragma("unroll") for (int m = 0; m < 4; ++m) _Pragma("unroll") for (int n = 0; n < 2; ++n) _Pragma("unroll") for (int k = 0; k < 2; ++k) \
        acc[ai][bj][m][n] = __builtin_amdgcn_mfma_f32_16x16x32_bf16(Bt[n][k], At[m][k], acc[ai][bj][m][n], 0, 0, 0); __builtin_amdgcn_s_setprio(0); } while (0)
#define PG8_WAIT_V(n) asm volatile("s_waitcnt vmcnt(" #n ")" ::: "memory")
#define PG8_WAIT_L(n) asm volatile("s_waitcnt lgkmcnt(" #n ")" ::: "memory")
#define PG8_BAR __builtin_amdgcn_s_barrier()
#define PG8_SCHED __builtin_amdgcn_sched_barrier(0)
#define PG8_APTR(u) ((const char*)g.A + (GATHER ? (size_t)0 : BMODE == 3 ? ((size_t)((u).z >> 2) * g.sAz + (size_t)((u).z & 3) * 512 + (size_t)(u).pm * BM * g.lda) * 2 : ((size_t)(u).z * g.sAz + (size_t)(u).pm * BM * g.lda) * 2))
#define PG8_BPTR(u) ((const char*)g.Bt + (BMODE == 1 ? ((size_t)(u).z * NTB + ((u).pn == 0 ? 0 : 256 + 2 * ((u).pn - 1))) * g.ldb * 2 \
                                          : BMODE == 2 ? ((size_t)((u).z >> 5) * 16777216 + (size_t)((u).z & 31) * 512 + (size_t)(u).pn * BM * g.ldb) * 2 \
                                          : BMODE == 3 ? ((size_t)((u).z >> 2) * g.sBz + (size_t)((u).z & 3) * 512 + (size_t)(u).pn * BM * g.ldb) * 2 \
                                          : ((size_t)(u).z * g.sBz + (size_t)(u).pn * BM * g.ldb) * 2))
#define PG8_BSEL(u, o, hb) do { if constexpr (BMODE == 1) { const bool c_ = ((u).pn == 0); o[0] = c_ ? bofN[0] : bofP[0]; o[1] = c_ ? bofN[1] : bofP[1]; hb = c_ ? hsB : (size_t)g.ldb * 2; } } while (0)
#define PG8_GOFF(u, o0, o1) do { if constexpr (GATHER) { const int* gp = g.gidx + (size_t)(u).z * g.gz + (u).pm * BM; _Pragma("unroll") for (int i = 0; i < 2; ++i) { \
        int r0 = gp[Rr[i]], r1 = gp[HALF + Rr[i]]; r0 = r0 < 0 ? 0 : r0; r1 = r1 < 0 ? 0 : r1; \
        o0[i] = ((unsigned)r0 * (unsigned)g.lda + (unsigned)Cc[i]) * 2u; o1[i] = ((unsigned)r1 * (unsigned)g.lda + (unsigned)Cc[i]) * 2u; } } } while (0)
    Unit cur, nxt; int ui = 0;
    if (!S.next(0, cur)) return;
    f32x4 acc[2][2][4][2];
#pragma unroll
    for (int a = 0; a < 2; ++a)
#pragma unroll
        for (int b = 0; b < 2; ++b)
#pragma unroll
            for (int m = 0; m < 4; ++m)
#pragma unroll
                for (int n = 0; n < 2; ++n) acc[a][b][m][n] = (f32x4){0.f, 0.f, 0.f, 0.f};
    bf16x8 At[4][2], B0[2][2], B1[2][2];
    const char* cA = PG8_APTR(cur); const char* cB = PG8_BPTR(cur);
    size_t hbc = hsB, hbn = hsB;
    PG8_GOFF(cur, aof0, aof1); PG8_BSEL(cur, bof0, hbc);
    PG8_STAGE(PG8_SB(0, 0), cB, bof0[0], bof0[1]); PG8_STAGE(PG8_SB(0, 1), cB + hbc, bof0[0], bof0[1]); PG8_STAGE(PG8_SA(0, 0), cA, aof0[0], aof0[1]); PG8_STAGE(PG8_SA(0, 1), cA + hsA, aof1[0], aof1[1]);
    if (wr == 1) PG8_BAR;
    PG8_WAIT_V(2); PG8_BAR;
    PG8_STAGE(PG8_SB(1, 0), cB + kstep, bof0[0], bof0[1]); PG8_STAGE(PG8_SA(1, 0), cA + kstep, aof0[0], aof0[1]); PG8_STAGE(PG8_SB(1, 1), cB + kstep + hbc, bof0[0], bof0[1]);
    PG8_WAIT_V(6); PG8_BAR;
    for (;;) {
        asm volatile("" : "+s"(cA), "+s"(cB));
        const bool has_next = S.next(ui + 1, nxt);
        const char* nA = has_next ? PG8_APTR(nxt) : cA; const char* nB = has_next ? PG8_BPTR(nxt) : cB;
        if constexpr (BMODE == 1) { if (has_next) { PG8_BSEL(nxt, nbof, hbn); } else { nbof[0] = bof0[0]; nbof[1] = bof0[1]; hbn = hbc; } }
        if constexpr (GATHER) { if (has_next) { PG8_GOFF(nxt, naof0, naof1); } else { naof0[0] = aof0[0]; naof0[1] = aof0[1]; naof1[0] = aof1[0]; naof1[1] = aof1[1]; } }
        for (int t = 0; t < nt; t += 2) {
            const bool last = (t == nt - 2);
            const char* a1 = cA + (size_t)(t + 1) * kstep;
            const char* a2 = last ? nA : cA + (size_t)(t + 2) * kstep; const char* b2 = last ? nB : cB + (size_t)(t + 2) * kstep;
            const char* a3 = a2 + kstep; const char* b3 = b2 + kstep;
            unsigned x00, x01, x10, x11;
            if constexpr (GATHER) { x00 = last ? naof0[0] : aof0[0]; x01 = last ? naof0[1] : aof0[1]; x10 = last ? naof1[0] : aof1[0]; x11 = last ? naof1[1] : aof1[1]; }
            else { x00 = aof0[0]; x01 = aof0[1]; x10 = aof0[0]; x11 = aof0[1]; }
            unsigned y0 = bof0[0], y1 = bof0[1];
            size_t hb2 = hsB;
            if constexpr (BMODE == 1) { y0 = last ? nbof[0] : bof0[0]; y1 = last ? nbof[1] : bof0[1]; hb2 = last ? hbn : hbc; }
            PG8_LDB(B0, 0, 0); PG8_LDB(B1, 0, 1); PG8_SCHED; PG8_LDA(At, 0, 0); PG8_STAGE(PG8_SA(1, 1), a1 + hsA, aof1[0], aof1[1]);
            PG8_WAIT_V(8); PG8_WAIT_L(0); PG8_BAR; PG8_MMA(0, 0, At, B0); PG8_MMA(0, 1, At, B1); PG8_BAR; PG8_SCHED;
            PG8_LDA(At, 0, 1); PG8_STAGE(PG8_SB(0, 0), b2, y0, y1); PG8_STAGE(PG8_SB(0, 1), b2 + hb2, y0, y1); PG8_STAGE(PG8_SA(0, 0), a2, x00, x01);
            PG8_WAIT_V(8); PG8_WAIT_L(0); PG8_BAR; PG8_MMA(1, 0, At, B0); PG8_MMA(1, 1, At, B1); PG8_BAR; PG8_SCHED;
            PG8_LDB(B0, 1, 0); PG8_LDB(B1, 1, 1); PG8_SCHED; PG8_LDA(At, 1, 0); PG8_STAGE(PG8_SA(0, 1), a2 + hsA, x10, x11);
            PG8_WAIT_V(8); PG8_WAIT_L(0); PG8_BAR; PG8_MMA(0, 0, At, B0); PG8_MMA(0, 1, At, B1); PG8_BAR; PG8_SCHED;
            PG8_LDA(At, 1, 1); PG8_STAGE(PG8_SB(1, 0), b3, y0, y1); PG8_STAGE(PG8_SB(1, 1), b3 + hb2, y0, y1); PG8_STAGE(PG8_SA(1, 0), a3, x00, x01);
            PG8_WAIT_V(8); PG8_WAIT_L(0); PG8_BAR; PG8_MMA(1, 0, At, B0); PG8_MMA(1, 1, At, B1); PG8_BAR; PG8_SCHED;
        }
        if constexpr (ALIGN_EPI) { if (wr == 0) PG8_BAR; }
        E(acc, cur, wr, wc, fr, fq);
        if (!has_next) break;
#pragma unroll
        for (int a = 0; a < 2; ++a)
#pragma unroll
            for (int b = 0; b < 2; ++b)
#pragma unroll
                for (int m = 0; m < 4; ++m)
#pragma unroll
                    for (int n = 0; n < 2; ++n) acc[a][b][m][n] = (f32x4){0.f, 0.f, 0.f, 0.f};
        cur = nxt; cA = nA; cB = nB; ++ui;
        if constexpr (GATHER) { aof0[0] = naof0[0]; aof0[1] = naof0[1]; aof1[0] = naof1[0]; aof1[1] = naof1[1]; }
        if constexpr (BMODE == 1) { bof0[0] = nbof[0]; bof0[1] = nbof[1]; hbc = hbn; }
        if constexpr (ALIGN_EPI) { if (wr == 1) PG8_BAR; }
    }
    PG8_WAIT_V(0);
    if constexpr (!ALIGN_EPI) { if (wr == 0) PG8_BAR; }
    PG8_BAR;
#undef PG8_SA
#undef PG8_SB
#undef PG8_STAGE
#undef PG8_LDA
#undef PG8_LDB
#undef PG8_MMA
#undef PG8_WAIT_V
#undef PG8_WAIT_L
#undef PG8_BAR
#undef PG8_SCHED
#undef PG8_APTR
#undef PG8_BPTR
#undef PG8_GOFF
#undef PG8_BSEL
}

__device__ __forceinline__ float grp_norm(float s) { s += __shfl_xor(s, 16); s += __shfl_xor(s, 32); return s; }
__device__ __forceinline__ void kmax_commit(unsigned* slot, float mx, int fr, int fq) {
#pragma unroll
    for (int o = 1; o < 16; o <<= 1) mx = fmaxf(mx, __shfl_xor(mx, o));
    if ((fr | fq) == 0) atomicMax(slot, __float_as_uint(mx));
}
struct EpiBf16 {
    static constexpr bool PERM = true;
    bf16_t* O; int ldc; int rows_per_z;
    __device__ __forceinline__ void operator()(const f32x4 (&acc)[2][2][4][2], const Unit& u, int wr, int wc, int fr, int fq) const {
        const size_t row0 = (size_t)u.z * rows_per_z + u.pm * BM + wr * 64 + fr; const int col0 = u.pn * BM + wc * 32 + 8 * fq;
#pragma unroll
        for (int ai = 0; ai < 2; ++ai)
#pragma unroll
            for (int m = 0; m < 4; ++m) { bf16_t* rowp = O + (row0 + ai * HALF + m * 16) * ldc + col0;
#pragma unroll
                for (int bj = 0; bj < 2; ++bj) { const f32x4 v0 = acc[ai][bj][m][0], v1 = acc[ai][bj][m][1];
                    v4u w; w.x = cvt_pk_bf16(v0[0], v0[1]); w.y = cvt_pk_bf16(v0[2], v0[3]); w.z = cvt_pk_bf16(v1[0], v1[1]); w.w = cvt_pk_bf16(v1[2], v1[3]);
                    *(v4u*)(rowp + bj * HALF) = w; } }
    }
};
struct EpiBf16Split {
    static constexpr bool PERM = true;
    bf16_t* O; size_t sec_stride; float scale0;
    unsigned* kmax; int ksec;
    __device__ __forceinline__ void operator()(const f32x4 (&acc)[2][2][4][2], const Unit& u, int wr, int wc, int fr, int fq) const {
        asm volatile("" : "+v"(fr), "+v"(fq));
        const int sec = u.pn >> 2; bf16_t* base = O + (size_t)sec * sec_stride; const float sc = (sec == 0) ? scale0 : 1.f;
        const size_t row0 = (size_t)u.pm * BM + wr * 64 + fr; const int col0 = (u.pn & 3) * BM + wc * 32 + 8 * fq;
#pragma unroll
        for (int ai = 0; ai < 2; ++ai)
#pragma unroll
            for (int m = 0; m < 4; ++m) { bf16_t* rowp = base + (row0 + ai * HALF + m * 16) * 1024 + col0;
#pragma unroll
                for (int bj = 0; bj < 2; ++bj) { const f32x4 v0 = acc[ai][bj][m][0] * sc, v1 = acc[ai][bj][m][1] * sc;
                    v4u w; w.x = cvt_pk_bf16(v0[0], v0[1]); w.y = cvt_pk_bf16(v0[2], v0[3]); w.z = cvt_pk_bf16(v1[0], v1[1]); w.w = cvt_pk_bf16(v1[2], v1[3]);
                    *(v4u*)(rowp + bj * HALF) = w; } }
        if (kmax != nullptr && sec == ksec) { float mx0 = 0.f, mx1 = 0.f;
#pragma unroll
            for (int ai = 0; ai < 2; ++ai)
#pragma unroll
                for (int m = 0; m < 4; ++m) {
                    { const f32x4 a = acc[ai][0][m][0], b = acc[ai][0][m][1]; mx0 = fmaxf(mx0, grp_norm((a[0] * a[0] + a[1] * a[1]) + (a[2] * a[2] + a[3] * a[3]) + (b[0] * b[0] + b[1] * b[1]) + (b[2] * b[2] + b[3] * b[3]))); }
                    { const f32x4 a = acc[ai][1][m][0], b = acc[ai][1][m][1]; mx1 = fmaxf(mx1, grp_norm((a[0] * a[0] + a[1] * a[1]) + (a[2] * a[2] + a[3] * a[3]) + (b[0] * b[0] + b[1] * b[1]) + (b[2] * b[2] + b[3] * b[3]))); } }
            const int bb = u.pm / 33, hd = (u.pn & 3) * 4 + (wc >> 1), g = wc & 1;
            kmax_commit(kmax + ((bb * 16 + hd) * 2 + g), mx0, fr, fq); kmax_commit(kmax + ((bb * 16 + hd + 2) * 2 + g), mx1, fr, fq); }
    }
};
struct EpiF32 {
    static constexpr bool PERM = false;
    float* C; int ldc;
    __device__ __forceinline__ void operator()(const f32x4 (&acc)[2][2][4][2], const Unit& u, int wr, int wc, int fr, int fq) const {
        const size_t row0 = (size_t)u.pm * BM + wr * 64 + fr; const int col0 = u.pn * BM + wc * 32 + 4 * fq;
#pragma unroll
        for (int ai = 0; ai < 2; ++ai)
#pragma unroll
            for (int m = 0; m < 4; ++m) { float* rowp = C + (row0 + ai * HALF + m * 16) * ldc + col0;
#pragma unroll
                for (int bj = 0; bj < 2; ++bj)
#pragma unroll
                    for (int n = 0; n < 2; ++n) *(f32x4*)(rowp + bj * HALF + n * 16) = acc[ai][bj][m][n]; }
    }
};
struct EpiResid {
    static constexpr bool PERM = true;
    xres_t* X; const long long* gmod;
    int rows_per_z, row_off;
    __device__ __forceinline__ void operator()(const f32x4 (&acc)[2][2][4][2], const Unit& u, int wr, int wc, int fr, int fq) const {
        const int row0 = u.z * rows_per_z + row_off + u.pm * BM + wr * 64 + fr; const int col0 = u.pn * BM + wc * 32 + 8 * fq;
        const int mi = midx_of_row(u.z * rows_per_z + row_off + u.pm * BM);
        f32x4 gv[2][2];
#pragma unroll
        for (int bj = 0; bj < 2; ++bj)
#pragma unroll
            for (int n = 0; n < 2; ++n) gv[bj][n] = ldmod4(gmod + (size_t)mi * 6144 + col0 + bj * HALF + n * 4);
#pragma unroll
        for (int ai = 0; ai < 2; ++ai)
#pragma unroll
            for (int m = 0; m < 4; ++m) { xres_t* rowp = X + (size_t)(row0 + ai * HALF + m * 16) * DM + col0;
#pragma unroll
                for (int bj = 0; bj < 2; ++bj) { xres_t* p = rowp + bj * HALF; f32x4 x0, x1; ldx8(p, x0, x1); stx8(p, x0 + gv[bj][0] * acc[ai][bj][m][0], x1 + gv[bj][1] * acc[ai][bj][m][1]); }
                if (m == 3) asm volatile("" ::: "memory"); }
    }
};
struct EpiQKVRope {
    static constexpr bool PERM = false;
    unsigned* kmax;
    bf16_t* O; size_t sec_stride; const float* tab; float qscale;
    __device__ __forceinline__ void operator()(const f32x4 (&acc)[2][2][4][2], const Unit& u, int wr, int wc, int fr, int fq) const {
        const int sec = u.pn >> 2; bf16_t* base = O + (size_t)sec * sec_stride;
        const size_t row0 = (size_t)u.pm * BM + wr * 64 + fr;
        const int pmb = u.pm % 33;
        if (sec == 2) {
            const int col0 = (u.pn & 3) * BM + wc * 32 + 4 * fq;
#pragma unroll
            for (int ai = 0; ai < 2; ++ai)
#pragma unroll
                for (int m = 0; m < 4; ++m) { bf16_t* rowp = base + (row0 + ai * HALF + m * 16) * 1024 + col0;
#pragma unroll
                    for (int bj = 0; bj < 2; ++bj)
#pragma unroll
                        for (int n = 0; n < 2; ++n) { const f32x4 v = acc[ai][bj][m][n]; v2u w; w.x = cvt_pk_bf16(v[0], v[1]); w.y = cvt_pk_bf16(v[2], v[3]); *(v2u*)(rowp + bj * HALF + n * 16) = w; } }
        } else {
            const int colh = ((u.pn & 3) * 4 + wc) * 64 + 4 * fq;
            float mx0 = 0.f, mx1 = 0.f;
#pragma unroll
            for (int ai = 0; ai < 2; ++ai)
#pragma unroll
                for (int m = 0; m < 4; ++m) { bf16_t* rowp = base + (row0 + ai * HALF + m * 16) * 1024 + colh;
                    const int gr = 4 * (pmb - 1) + 2 * ai + wr, gc = 16 * m + fr; float s1 = 0.f, s2 = 0.f;
#pragma unroll
                    for (int n = 0; n < 2; ++n) {
                        f32x4 cs = (f32x4){1.f, 1.f, 1.f, 1.f}, sn = (f32x4){0.f, 0.f, 0.f, 0.f};
                        if (pmb != 0) { const int ti = (n == 0 ? gr : 128 + gc) * 16 + 4 * fq; cs = *(const f32x4*)(tab + TAB_COS64 + ti); sn = *(const f32x4*)(tab + TAB_SIN64 + ti); }
                        const f32x4 t1 = acc[ai][0][m][n], t2 = acc[ai][1][m][n];
                        const float qs = (sec == 0) ? qscale : 1.f;
                        const f32x4 o1 = (t1 * cs - t2 * sn) * qs, o2 = (t2 * cs + t1 * sn) * qs;
                        v2u w1, w2; w1.x = cvt_pk_bf16(o1[0], o1[1]); w1.y = cvt_pk_bf16(o1[2], o1[3]); w2.x = cvt_pk_bf16(o2[0], o2[1]); w2.y = cvt_pk_bf16(o2[2], o2[3]);
                        *(v2u*)(rowp + n * 16) = w1; *(v2u*)(rowp + 32 + n * 16) = w2;
                        s1 += (o1[0] * o1[0] + o1[1] * o1[1]) + (o1[2] * o1[2] + o1[3] * o1[3]); s2 += (o2[0] * o2[0] + o2[1] * o2[1]) + (o2[2] * o2[2] + o2[3] * o2[3]); }
                    if (sec == 1) { mx0 = fmaxf(mx0, grp_norm(s1)); mx1 = fmaxf(mx1, grp_norm(s2)); } }
            if (sec == 1) { const int bb = u.pm / 33, sub = (u.pn & 3) * 4 + wc;
                kmax_commit(kmax + ((bb * 16 + sub) * 2 + 0), mx0, fr, fq); kmax_commit(kmax + ((bb * 16 + sub) * 2 + 1), mx1, fr, fq); }
        }
    }
};
struct EpiMlaQ {
    static constexpr bool PERM = false;
    bf16_t* QN; bf16_t* QR; const float* tab; float qscale;
    __device__ __forceinline__ void operator()(const f32x4 (&acc)[2][2][4][2], const Unit& u, int wr, int wc, int fr, int fq) const {
        const size_t row0 = (size_t)u.pm * BM + wr * 64 + fr; const int pmb = u.pm % 33;
        if (u.pn < 4) {
            const int col0 = u.pn * BM + wc * 32 + 4 * fq;
#pragma unroll
            for (int ai = 0; ai < 2; ++ai)
#pragma unroll
                for (int m = 0; m < 4; ++m) { bf16_t* rowp = QN + (row0 + ai * HALF + m * 16) * 1024 + col0;
#pragma unroll
                    for (int bj = 0; bj < 2; ++bj)
#pragma unroll
                        for (int n = 0; n < 2; ++n) { const f32x4 v = acc[ai][bj][m][n] * qscale; v2u w; w.x = cvt_pk_bf16(v[0], v[1]); w.y = cvt_pk_bf16(v[2], v[3]); *(v2u*)(rowp + bj * HALF + n * 16) = w; } }
        } else {
#pragma unroll
            for (int ai = 0; ai < 2; ++ai)
#pragma unroll
                for (int m = 0; m < 4; ++m) {
                    const int gr = 4 * (pmb - 1) + 2 * ai + wr, gc = 16 * m + fr;
                    f32x4 cs = (f32x4){1.f, 1.f, 1.f, 1.f}, sn = (f32x4){0.f, 0.f, 0.f, 0.f};
                    if (pmb != 0) { const int ti = (fq < 2 ? gr : 128 + gc) * 8 + 4 * (fq & 1); cs = *(const f32x4*)(tab + TAB_COS32 + ti); sn = *(const f32x4*)(tab + TAB_SIN32 + ti); }
#pragma unroll
                    for (int n = 0; n < 2; ++n) {
                        const int head = (u.pn - 4) * 8 + 2 * wc + n;
                        bf16_t* rowp = QR + (row0 + ai * HALF + m * 16) * 512 + head * 32 + 4 * fq;
                        const f32x4 t1 = acc[ai][0][m][n], t2 = acc[ai][1][m][n];
                        const f32x4 o1 = (t1 * cs - t2 * sn) * qscale, o2 = (t2 * cs + t1 * sn) * qscale;
                        v2u w1, w2; w1.x = cvt_pk_bf16(o1[0], o1[1]); w1.y = cvt_pk_bf16(o1[2], o1[3]); w2.x = cvt_pk_bf16(o2[0], o2[1]); w2.y = cvt_pk_bf16(o2[2], o2[3]);
                        *(v2u*)(rowp) = w1; *(v2u*)(rowp + 16) = w2; } }
        }
    }
};
struct EpiGateUp {
    static constexpr bool PERM = true;
    bf16_t* ACT;
    __device__ __forceinline__ void operator()(const f32x4 (&acc)[2][2][4][2], const Unit& u, int wr, int wc, int fr, int fq) const {
        const size_t row0 = (size_t)u.z * SLOTS_E + u.pm * BM + wr * 64 + fr; const int col0 = u.pn * HALF + wc * 32 + 8 * fq;
#pragma unroll
        for (int ai = 0; ai < 2; ++ai)
#pragma unroll
            for (int m = 0; m < 4; ++m) { bf16_t* rowp = ACT + (row0 + ai * HALF + m * 16) * EDIM + col0;
                float r[8];
#pragma unroll
                for (int n = 0; n < 2; ++n)
#pragma unroll
                    for (int i = 0; i < 4; ++i) { const float a = acc[ai][0][m][n][i], b = acc[ai][1][m][n][i];
                        r[n * 4 + i] = a * __builtin_amdgcn_rcpf(1.f + __builtin_amdgcn_exp2f(-a * LOG2E)) * b; }
                v4u w; w.x = cvt_pk_bf16(r[0], r[1]); w.y = cvt_pk_bf16(r[2], r[3]); w.z = cvt_pk_bf16(r[4], r[5]); w.w = cvt_pk_bf16(r[6], r[7]);
                *(v4u*)rowp = w; }
    }
};
struct EpiDown {
    static constexpr bool PERM = true;
    bf16_t* Y; const float* gate;
    __device__ __forceinline__ void operator()(const f32x4 (&acc)[2][2][4][2], const Unit& u, int wr, int wc, int fr, int fq) const {
        const size_t row0 = (size_t)u.z * SLOTS_E + u.pm * BM + wr * 64 + fr; const int col0 = u.pn * BM + wc * 32 + 8 * fq;
#pragma unroll
        for (int ai = 0; ai < 2; ++ai)
#pragma unroll
            for (int m = 0; m < 4; ++m) { const size_t row = row0 + ai * HALF + m * 16; const float gt = gate[row]; bf16_t* rowp = Y + row * DM + col0;
#pragma unroll
                for (int bj = 0; bj < 2; ++bj) { const f32x4 v0 = acc[ai][bj][m][0] * gt, v1 = acc[ai][bj][m][1] * gt;
                    v4u w; w.x = cvt_pk_bf16(v0[0], v0[1]); w.y = cvt_pk_bf16(v0[2], v0[3]); w.z = cvt_pk_bf16(v1[0], v1[1]); w.w = cvt_pk_bf16(v1[2], v1[3]);
                    *(v4u*)(rowp + bj * HALF) = w; } }
    }
};
struct EpiDownCtx {
    static constexpr bool PERM = false;
    float* YC; const float* gate;
    __device__ __forceinline__ void operator()(const f32x4 (&acc)[2][2][4][2], const Unit& u, int wr, int wc, int fr, int fq) const {
        const int e = u.z >> 2, kq = u.z & 3; const int col0 = u.pn * BM + wc * 32 + 4 * fq;
#pragma unroll
        for (int m = 0; m < 4; ++m) { const int rt = wr * 64 + m * 16 + fr; const float gt = gate[(size_t)e * SLOTS_E + 4096 + rt];
            float* rowp = YC + ((size_t)kq * (NEXP * 128) + e * 128 + rt) * DM + col0;
#pragma unroll
            for (int bj = 0; bj < 2; ++bj)
#pragma unroll
                for (int n = 0; n < 2; ++n) *(f32x4*)(rowp + bj * HALF + n * 16) = acc[0][bj][m][n] * gt; }
    }
};
struct EpiFnT {
    static constexpr bool PERM = true;
    bf16_t* TT; bf16_t* TTC;
    __device__ __forceinline__ void operator()(const f32x4 (&acc)[2][2][4][2], const Unit& u, int wr, int wc, int fr, int fq) const {
        const int b = u.z; const int m0 = u.pm * BM + wr * 64 + fr;
#pragma unroll
        for (int ai = 0; ai < 2; ++ai)
#pragma unroll
            for (int m = 0; m < 4; ++m) { const int mm = m0 + ai * HALF + m * 16; const int part = mm >> 10, c = mm & 1023;
#pragma unroll
                for (int bj = 0; bj < 2; ++bj) { const f32x4 v0 = acc[ai][bj][m][0], v1 = acc[ai][bj][m][1];
                    v4u w; w.x = cvt_pk_bf16(v0[0], v0[1]); w.y = cvt_pk_bf16(v0[2], v0[3]); w.z = cvt_pk_bf16(v1[0], v1[1]); w.w = cvt_pk_bf16(v1[2], v1[3]);
                    bf16_t* p = (u.pn == 0) ? TTC + ((size_t)(c * 4 + b) * 2 + part) * 256 + bj * HALF + wc * 32 + 8 * fq
                                            : TT + ((((size_t)b * 1024 + c) * 64 + 2 * (u.pn - 1) + bj) * 2 + part) * 128 + wc * 32 + 8 * fq;
                    *(v4u*)p = w; } }
    }
};
struct EpiFA {
    static constexpr bool PERM = true;
    bf16_t* G2;
    __device__ __forceinline__ void operator()(const f32x4 (&acc)[2][2][4][2], const Unit& u, int wr, int wc, int fr, int fq) const {
        asm volatile("" : "+v"(fr), "+v"(fq));
#pragma unroll
        for (int m = 0; m < 4; ++m) { const int k2 = wr * 64 + m * 16 + fr;
#pragma unroll
            for (int bj = 0; bj < 2; ++bj) { const int ng = u.pn * BM + bj * HALF + wc * 32 + 8 * fq; const int bc = ng >> 6, n1 = ng & 63;
                bf16_t* p = G2 + (((size_t)bc * 128 + k2) * 2) * 64 + n1;
#pragma unroll
                for (int n = 0; n < 2; ++n) { float gr[4], gi[4];
#pragma unroll
                    for (int q = 0; q < 4; ++q) { const float rev = (float)((k2 * (n1 + 4 * n + q)) & 8191) * (1.f / 8192.f); const float cs = __builtin_amdgcn_cosf(rev), sn = __builtin_amdgcn_sinf(rev);
                        const float a = acc[0][bj][m][n][q], bb = acc[1][bj][m][n][q]; gr[q] = a * cs - bb * sn; gi[q] = a * sn + bb * cs; }
                    v2u w; w.x = cvt_pk_bf16(gr[0], gr[1]); w.y = cvt_pk_bf16(gr[2], gr[3]); *(v2u*)(p + 4 * n) = w;
                    v2u x; x.x = cvt_pk_bf16(gi[0], gi[1]); x.y = cvt_pk_bf16(gi[2], gi[3]); *(v2u*)(p + 64 + 4 * n) = x;
                    asm volatile("" ::: "memory"); } } }
    }
};
struct EpiFC {
    static constexpr bool PERM = true;
    xres_t* X; const long long* gmod;
    __device__ __forceinline__ void operator()(const f32x4 (&acc)[2][2][4][2], const Unit& u, int wr, int wc, int fr, int fq) const {
        const int b = u.z >> 5, q = u.z & 31; const int col0 = u.pn * BM + wc * 32 + 8 * fq;
        f32x4 gv[2][2];
#pragma unroll
        for (int bj = 0; bj < 2; ++bj)
#pragma unroll
            for (int n = 0; n < 2; ++n) gv[bj][n] = ldmod4(gmod + (size_t)b * 6144 + col0 + bj * HALF + n * 4);
#pragma unroll
        for (int ai = 0; ai < 2; ++ai)
#pragma unroll
            for (int m = 0; m < 4; ++m) { const int j = 2 * ai + wr, k1 = 16 * m + fr; const int pos = 128 * k1 + 4 * q + j;
                xres_t* rowp = X + ((size_t)b * NTB + CTXL + pos) * DM + col0;
#pragma unroll
                for (int bj = 0; bj < 2; ++bj) { xres_t* p = rowp + bj * HALF; f32x4 x0, x1; ldx8(p, x0, x1); stx8(p, x0 + gv[bj][0] * acc[ai][bj][m][0], x1 + gv[bj][1] * acc[ai][bj][m][1]); }
                if (m == 3) asm volatile("" ::: "memory"); }
    }
};
}

namespace att {
constexpr int NW = 8, QBLK = 32, KVBLK = 64;
constexpr float ATT_LIM = 64.f;
#define SBAR() __builtin_amdgcn_sched_barrier(0)
__device__ __forceinline__ int crow(int r, int hi) { return (r & 3) + 8 * (r >> 2) + 4 * hi; }

template <int DQK, int DV> struct Cfg {
    static constexpr int KP = (DQK == 64) ? 128 : 256;
    static constexpr int SHM_K = KVBLK * KP, SHM_V = KVBLK * DV * 2, NCB = DV / 32, ND0 = DQK / 16;
    static constexpr int NBUF = 3;
    static constexpr int OFF_V = 0, OFF_K = NBUF * SHM_V, OFF_WS = NBUF * SHM_V + NBUF * SHM_K, OFF_AUX = OFF_WS + NW * 64 * 4, BYTES = OFF_AUX + 4096;
};
struct Ptrs {
    const bf16_t* q1; const bf16_t* q2; int ldq1, ldq2;
    const bf16_t* k1; const bf16_t* k2; int ldk1, ldk2;
    const bf16_t* v; int ldv;
};

__device__ __forceinline__ void partialSM(f32x16& p0, f32x16& p1, float& m_reg, float& mn, float& alpha, float THRL, bool fast) {
    if (fast) {
        mn = 0.f; alpha = 1.f;
    } else {
        float pmax = p0[0];
#pragma unroll
        for (int r = 1; r < 16; ++r) pmax = fmaxf(pmax, p0[r]);
#pragma unroll
        for (int r = 0; r < 16; ++r) pmax = fmaxf(pmax, p1[r]);
        { auto rr = __builtin_amdgcn_permlane32_swap(__float_as_uint(pmax), __float_as_uint(pmax), false, false);
          pmax = fmaxf(__uint_as_float(rr[0]), __uint_as_float(rr[1])); }
        if (__builtin_expect(__all(pmax - m_reg <= THRL), 1)) { mn = m_reg; alpha = 1.f; }
        else { mn = fmaxf(m_reg, pmax); alpha = __builtin_amdgcn_exp2f(m_reg - mn); m_reg = mn; }
        if (!__builtin_expect(__all(mn == 0.f), 1)) {
#pragma unroll
            for (int r = 0; r < 16; ++r) { p0[r] -= mn; p1[r] -= mn; }
        }
    }
#pragma unroll
    for (int r = 0; r < 16; ++r) p0[r] = __builtin_amdgcn_exp2f(p0[r]);
}
__device__ __forceinline__ void finishSM(f32x16& p0, f32x16& p1, float alpha, float& l_reg, bf16x8& pa0, bf16x8& pa1, bf16x8& pa2, bf16x8& pa3) {
#pragma unroll
    for (int r = 0; r < 16; ++r) p1[r] = __builtin_amdgcn_exp2f(p1[r]);
    float ps = 0;
#pragma unroll
    for (int r = 0; r < 16; ++r) ps += p0[r];
#pragma unroll
    for (int r = 0; r < 16; ++r) ps += p1[r];
    { auto rr = __builtin_amdgcn_permlane32_swap(__float_as_uint(ps), __float_as_uint(ps), false, false);
      ps = __uint_as_float(rr[0]) + __uint_as_float(rr[1]); }
    l_reg = l_reg * alpha + ps;
#define PK4(P, BASE, OUT) do { unsigned a0 = cvt_pk_bf16(P[BASE + 0], P[BASE + 1]), a1 = cvt_pk_bf16(P[BASE + 2], P[BASE + 3]);   \
    unsigned b0 = cvt_pk_bf16(P[BASE + 4], P[BASE + 5]), b1 = cvt_pk_bf16(P[BASE + 6], P[BASE + 7]);                              \
    auto r0 = __builtin_amdgcn_permlane32_swap(a0, b0, false, false); auto r1 = __builtin_amdgcn_permlane32_swap(a1, b1, false, false); \
    v4u w = {r0[0], r1[0], r0[1], r1[1]}; OUT = __builtin_bit_cast(bf16x8, w); } while (0)
    PK4(p0, 0, pa0); PK4(p0, 8, pa1); PK4(p1, 0, pa2); PK4(p1, 8, pa3);
#undef PK4
}
template <int DQK> __device__ __forceinline__ void qkt(f32x16& p0, f32x16& p1, const char* Ks, const bf16x8* qr, int r32, int hi) {
    constexpr int KP = Cfg<DQK, 64>::KP;
    p0 = f32x16{}; p1 = f32x16{};
#pragma unroll
    for (int d0 = 0; d0 < DQK / 16; ++d0) { const int cb = (d0 * 16 + hi * 8) * 2;
        const bf16x8 b0 = *reinterpret_cast<const bf16x8*>(Ks + r32 * KP + (cb ^ ((r32 & 7) << 4)));
        const bf16x8 b1 = *reinterpret_cast<const bf16x8*>(Ks + (32 + r32) * KP + (cb ^ ((r32 & 7) << 4)));
        p0 = __builtin_amdgcn_mfma_f32_32x32x16_bf16(b0, qr[d0], p0, 0, 0, 0);
        p1 = __builtin_amdgcn_mfma_f32_32x32x16_bf16(b1, qr[d0], p1, 0, 0, 0); }
}
template <int NCB> __device__ __forceinline__ int v_st(int k, int c) { const int kk = (k & ~0xC) | ((k & 4) << 1) | ((k & 8) >> 1); return ((kk >> 3) * NCB + (c >> 5)) * 512 + ((kk & 7) * 32 + (c & 31)) * 2; }
__device__ __forceinline__ int v_rd_base(int lane) { return ((lane & 3) << 3) | (((lane >> 2) & 3) << 6) | (((lane >> 4) & 1) << 5) | (((lane >> 5) & 1) << 8); }
template <int OFF> __device__ __forceinline__ s16x4 tr_read(int vb) {
    s16x4 r; asm volatile("ds_read_b64_tr_b16 %0, %1 offset:%2" : "=&v"(r) : "v"(vb), "i"(OFF) : "memory"); return r;
}
template <int NCB, int D0> __device__ __forceinline__ void pv_rd(s16x4 (&L)[4], s16x4 (&H)[4], int vb) {
    constexpr int KS = NCB * 1024, HF = NCB * 512;
    L[0] = tr_read<D0 * 512 + 0 * KS>(vb); H[0] = tr_read<D0 * 512 + 0 * KS + HF>(vb); L[1] = tr_read<D0 * 512 + 1 * KS>(vb); H[1] = tr_read<D0 * 512 + 1 * KS + HF>(vb);
    L[2] = tr_read<D0 * 512 + 2 * KS>(vb); H[2] = tr_read<D0 * 512 + 2 * KS + HF>(vb); L[3] = tr_read<D0 * 512 + 3 * KS>(vb); H[3] = tr_read<D0 * 512 + 3 * KS + HF>(vb);
}
__device__ __forceinline__ void pv_mm(f32x16& od, const s16x4 (&L)[4], const s16x4 (&H)[4], bf16x8 pa0, bf16x8 pa1, bf16x8 pa2, bf16x8 pa3) {
#define PK(k) (bf16x8){L[k][0], L[k][1], L[k][2], L[k][3], H[k][0], H[k][1], H[k][2], H[k][3]}
    od = __builtin_amdgcn_mfma_f32_32x32x16_bf16(pa0, PK(0), od, 0, 0, 0);
    od = __builtin_amdgcn_mfma_f32_32x32x16_bf16(pa1, PK(1), od, 0, 0, 0);
    od = __builtin_amdgcn_mfma_f32_32x32x16_bf16(pa2, PK(2), od, 0, 0, 0);
    od = __builtin_amdgcn_mfma_f32_32x32x16_bf16(pa3, PK(3), od, 0, 0, 0);
#undef PK
}
template <int NCB> __device__ __forceinline__ void pv_all(f32x16* o, int vb, bf16x8 pa0, bf16x8 pa1, bf16x8 pa2, bf16x8 pa3) {
    s16x4 L[4], H[4];
    pv_rd<NCB, 0>(L, H, vb); asm volatile("s_waitcnt lgkmcnt(0)" ::: "memory"); SBAR(); pv_mm(o[0], L, H, pa0, pa1, pa2, pa3);
    pv_rd<NCB, 1>(L, H, vb); asm volatile("s_waitcnt lgkmcnt(0)" ::: "memory"); SBAR(); pv_mm(o[1], L, H, pa0, pa1, pa2, pa3);
    if constexpr (NCB == 4) {
        pv_rd<NCB, 2>(L, H, vb); asm volatile("s_waitcnt lgkmcnt(0)" ::: "memory"); SBAR(); pv_mm(o[2], L, H, pa0, pa1, pa2, pa3);
        pv_rd<NCB, 3>(L, H, vb); asm volatile("s_waitcnt lgkmcnt(0)" ::: "memory"); SBAR(); pv_mm(o[3], L, H, pa0, pa1, pa2, pa3);
    }
}

typedef short v4i16_t __attribute__((ext_vector_type(4)));
template <int OFF> __device__ __forceinline__ s16x4 tr_ld(int vb) {
    return __builtin_bit_cast(s16x4, __builtin_amdgcn_ds_read_tr16_b64_v4i16((__attribute__((address_space(3))) v4i16_t*)(vb + OFF)));
}
template <int NCB, int D0> __device__ __forceinline__ void pvf_one(f32x16& od, int vb, bf16x8 pa0, bf16x8 pa1, bf16x8 pa2, bf16x8 pa3) {
    constexpr int KS = NCB * 1024, HF = NCB * 512;
    const s16x4 l0 = tr_ld<D0 * 512 + 0 * KS>(vb), h0 = tr_ld<D0 * 512 + 0 * KS + HF>(vb), l1 = tr_ld<D0 * 512 + 1 * KS>(vb), h1 = tr_ld<D0 * 512 + 1 * KS + HF>(vb);
    const s16x4 l2 = tr_ld<D0 * 512 + 2 * KS>(vb), h2 = tr_ld<D0 * 512 + 2 * KS + HF>(vb), l3 = tr_ld<D0 * 512 + 3 * KS>(vb), h3 = tr_ld<D0 * 512 + 3 * KS + HF>(vb);
#define PKF(L, H) (bf16x8){L[0], L[1], L[2], L[3], H[0], H[1], H[2], H[3]}
    od = __builtin_amdgcn_mfma_f32_32x32x16_bf16(pa0, PKF(l0, h0), od, 0, 0, 0);
    od = __builtin_amdgcn_mfma_f32_32x32x16_bf16(pa1, PKF(l1, h1), od, 0, 0, 0);
    od = __builtin_amdgcn_mfma_f32_32x32x16_bf16(pa2, PKF(l2, h2), od, 0, 0, 0);
    od = __builtin_amdgcn_mfma_f32_32x32x16_bf16(pa3, PKF(l3, h3), od, 0, 0, 0);
#undef PKF
}
template <int NCB> __device__ __forceinline__ void pvf_all(f32x16* o, int vb, bf16x8 pa0, bf16x8 pa1, bf16x8 pa2, bf16x8 pa3) {
    pvf_one<NCB, 0>(o[0], vb, pa0, pa1, pa2, pa3); pvf_one<NCB, 1>(o[1], vb, pa0, pa1, pa2, pa3);
    if constexpr (NCB == 4) { pvf_one<NCB, 2>(o[2], vb, pa0, pa1, pa2, pa3); pvf_one<NCB, 3>(o[3], vb, pa0, pa1, pa2, pa3); }
}
template <int LO> __device__ __forceinline__ void exp8(f32x16& p, float& ps) {
#pragma unroll
    for (int r = LO; r < LO + 8; ++r) p[r] = __builtin_amdgcn_exp2f(p[r]);
#pragma unroll
    for (int r = LO; r < LO + 8; ++r) ps += p[r];
}
__device__ __forceinline__ void lsum(float ps, float& l_reg) {
    auto rr = __builtin_amdgcn_permlane32_swap(__float_as_uint(ps), __float_as_uint(ps), false, false); l_reg += __uint_as_float(rr[0]) + __uint_as_float(rr[1]);
}
__device__ __forceinline__ void expsum(f32x16& p0, f32x16& p1, float& l_reg) {
    float ps = 0.f; exp8<0>(p0, ps); exp8<8>(p0, ps); exp8<0>(p1, ps); exp8<8>(p1, ps); lsum(ps, l_reg);
}
template <int NCB> __device__ __forceinline__ void pv_exp(f32x16* o, int vb, bf16x8 pa0, bf16x8 pa1, bf16x8 pa2, bf16x8 pa3, f32x16& p0, f32x16& p1, float& ps) {
    pvf_one<NCB, 0>(o[0], vb, pa0, pa1, pa2, pa3); exp8<0>(p0, ps); asm volatile("" : "+v"(p0), "+v"(ps)); SBAR();
    pvf_one<NCB, 1>(o[1], vb, pa0, pa1, pa2, pa3); exp8<8>(p0, ps); asm volatile("" : "+v"(p0), "+v"(ps)); SBAR();
    if constexpr (NCB == 4) {
        pvf_one<NCB, 2>(o[2], vb, pa0, pa1, pa2, pa3); exp8<0>(p1, ps); asm volatile("" : "+v"(p1), "+v"(ps)); SBAR();
        pvf_one<NCB, 3>(o[3], vb, pa0, pa1, pa2, pa3); exp8<8>(p1, ps); asm volatile("" : "+v"(p1), "+v"(ps)); SBAR();
    }
}
__device__ __forceinline__ void packp(const f32x16& p0, const f32x16& p1, bf16x8& pa0, bf16x8& pa1, bf16x8& pa2, bf16x8& pa3) {
#define PK4(P, BASE, OUT) do { unsigned a0 = cvt_pk_bf16(P[BASE + 0], P[BASE + 1]), a1 = cvt_pk_bf16(P[BASE + 2], P[BASE + 3]);   \
    unsigned b0 = cvt_pk_bf16(P[BASE + 4], P[BASE + 5]), b1 = cvt_pk_bf16(P[BASE + 6], P[BASE + 7]);                              \
    auto r0 = __builtin_amdgcn_permlane32_swap(a0, b0, false, false); auto r1 = __builtin_amdgcn_permlane32_swap(a1, b1, false, false); \
    v4u w = {r0[0], r1[0], r0[1], r1[1]}; OUT = __builtin_bit_cast(bf16x8, w); } while (0)
    PK4(p0, 0, pa0); PK4(p0, 8, pa1); PK4(p1, 0, pa2); PK4(p1, 8, pa3);
#undef PK4
}

template <int DQK> __device__ __forceinline__ bool rows_bounded(const Ptrs& P, float k2max, float lim) {
    const int tid = threadIdx.x, wid = tid >> 6, lane = tid & 63, r32 = lane & 31, hi = lane >> 5;
    float q2 = 0.f;
    { const bf16_t* Qw = P.q1 + (long)(wid * QBLK + r32) * P.ldq1 + hi * 8;
#pragma unroll
      for (int d0 = 0; d0 < 4; ++d0) { const bf16x8 q = *reinterpret_cast<const bf16x8*>(Qw + d0 * 16);
#pragma unroll
          for (int e2 = 0; e2 < 8; ++e2) { const float f = __builtin_bit_cast(float, (unsigned)(unsigned short)q[e2] << 16); q2 += f * f; } }
      if constexpr (DQK == 96) { const bf16_t* Qw2 = P.q2 + (long)(wid * QBLK + r32) * P.ldq2 + hi * 8;
#pragma unroll
        for (int d0 = 0; d0 < 2; ++d0) { const bf16x8 q = *reinterpret_cast<const bf16x8*>(Qw2 + d0 * 16);
#pragma unroll
            for (int e2 = 0; e2 < 8; ++e2) { const float f = __builtin_bit_cast(float, (unsigned)(unsigned short)q[e2] << 16); q2 += f * f; } } } }
    { auto rr = __builtin_amdgcn_permlane32_swap(__float_as_uint(q2), __float_as_uint(q2), false, false); q2 = __uint_as_float(rr[0]) + __uint_as_float(rr[1]); }
    return (lim > 0.f) && __all(q2 * k2max * 1.03f <= lim * lim);
}
template <bool FAST, int DQK, int DV, class TileMap, class Mask, class Epi>
__device__ __forceinline__ void body(const Ptrs& P, int NT, const TileMap& TM, const Mask& MK, const Epi& EP, float THRL, char* lds) {
    using CF = Cfg<DQK, DV>; constexpr int NCB = CF::NCB, ND0 = CF::ND0, KP = CF::KP;
    int tid = threadIdx.x; asm volatile("" : "+v"(tid));
    const int wid = tid >> 6, lane = tid & 63, r32 = lane & 31, hi = lane >> 5;
    char* V_lds = lds + CF::OFF_V; char* K_lds = lds + CF::OFF_K;
    float* ws = (float*)(lds + CF::OFF_WS) + wid * 64; float* li_l = ws; float* al_l = ws + 32;
    float m_reg = 0.f, l_reg = 0; f32x16 o[NCB]; bf16x8 qr[ND0];
#pragma unroll
    for (int d = 0; d < NCB; ++d) o[d] = f32x16{};
    { const bf16_t* Qw = P.q1 + (long)(wid * QBLK + r32) * P.ldq1 + hi * 8;
#pragma unroll
      for (int d0 = 0; d0 < 4; ++d0) qr[d0] = *reinterpret_cast<const bf16x8*>(Qw + d0 * 16);
      if constexpr (DQK == 96) { const bf16_t* Qw2 = P.q2 + (long)(wid * QBLK + r32) * P.ldq2 + hi * 8;
#pragma unroll
        for (int d0 = 0; d0 < 2; ++d0) qr[4 + d0] = *reinterpret_cast<const bf16x8*>(Qw2 + d0 * 16); } }
    constexpr bool fast = FAST;
    const int kr_ = tid >> 3, kc_ = tid & 7;
    const int kst1 = kr_ * KP + ((kc_ * 16) ^ ((kr_ & 7) << 4));
    const int k2r = (tid & 255) >> 2, k2c = tid & 3;
    const int kst2 = k2r * KP + ((128 + k2c * 16) ^ ((k2r & 7) << 4));
    const int vsr = (DV == 128) ? (tid >> 4) : (tid >> 3), vsc = (DV == 128) ? (tid & 15) * 8 : (tid & 7) * 8;
    const int vst0 = v_st<NCB>(vsr, vsc), vst1 = v_st<NCB>(32 + vsr, vsc);
    const int vb0 = (int)(uintptr_t)V_lds + v_rd_base(lane);
    struct { bf16x8 k0, k1, v0, v1; } sr_[2];
    const unsigned kof1 = (unsigned)(kr_ * P.ldk1 + kc_ * 8) * 2u, kof2 = (DQK == 96) ? (unsigned)(k2r * P.ldk2 + k2c * 8) * 2u : 0u;
    const unsigned vof0 = (unsigned)(vsr * P.ldv + vsc) * 2u, vof1 = (unsigned)((32 + vsr) * P.ldv + vsc) * 2u;
#define SLOAD(i, j) do { const size_t k0_ = (size_t)TM(j); \
        const char* kb1_ = (const char*)P.k1 + k0_ * (size_t)P.ldk1 * 2; const char* vb_ = (const char*)P.v + k0_ * (size_t)P.ldv * 2; \
        sr_[i].k0 = *reinterpret_cast<const bf16x8*>(kb1_ + kof1); \
        if constexpr (DQK == 96) { const char* kb2_ = (const char*)P.k2 + k0_ * (size_t)P.ldk2 * 2; sr_[i].k1 = *reinterpret_cast<const bf16x8*>(kb2_ + kof2); } \
        sr_[i].v0 = *reinterpret_cast<const bf16x8*>(vb_ + vof0); \
        if constexpr (DV == 128) sr_[i].v1 = *reinterpret_cast<const bf16x8*>(vb_ + vof1); } while (0)
#define SWRITE(b, i) do { *(bf16x8*)(V_lds + (b) * CF::SHM_V + vst0) = sr_[i].v0; \
        if constexpr (DV == 128) *(bf16x8*)(V_lds + (b) * CF::SHM_V + vst1) = sr_[i].v1; \
        *(bf16x8*)(K_lds + (b) * CF::SHM_K + kst1) = sr_[i].k0; \
        if constexpr (DQK == 96) { if (tid < 256) *(bf16x8*)(K_lds + (b) * CF::SHM_K + kst2) = sr_[i].k1; } } while (0)
    constexpr int NLD = 2 + (DQK == 96 ? 1 : 0) + (DV == 128 ? 1 : 0);
#define SWAIT() do { if constexpr (NLD == 3) asm volatile("s_waitcnt vmcnt(3)" ::: "memory"); else if constexpr (NLD == 4) asm volatile("s_waitcnt vmcnt(4)" ::: "memory"); else asm volatile("s_waitcnt vmcnt(2)" ::: "memory"); } while (0)
#define RESC(a) do { if (__any((a) < 1.f)) { if (hi == 0) al_l[r32] = (a); asm volatile("s_waitcnt lgkmcnt(0)" ::: "memory"); \
        _Pragma("unroll") for (int d = 0; d < NCB; ++d) _Pragma("unroll") for (int r = 0; r < 16; ++r) o[d][r] *= al_l[crow(r, hi)]; } } while (0)
    f32x16 pA0, pA1, pB0, pB1; float mnA, mnB, alA, alB; bf16x8 pa0, pa1, pa2, pa3;
    constexpr int SE = 0, SO = 1;
    int bp = 0, bc = 1, bn = 2;
#define ROT3() do { const int t_ = bp; bp = bc; bc = bn; bn = t_; } while (0)
    SLOAD(SE, 0); asm volatile("s_waitcnt vmcnt(0)" ::: "memory"); SWRITE(0, SE); __syncthreads();
    if constexpr (FAST) {
        float psA = 0.f, psB = 0.f;
        qkt<DQK>(pA0, pA1, K_lds, qr, r32, hi); MK(pA0, pA1, 0); exp8<0>(pA0, psA); exp8<8>(pA0, psA); if constexpr (NCB == 4) { exp8<0>(pA1, psA); exp8<8>(pA1, psA); }
        SLOAD(SO, 1); if (2 < NT) SLOAD(SE, 2);
        SWAIT(); SWRITE(1, SO); __syncthreads();
#define FSTEP(PC0, PC1, PP0, PP1, PSC, PSP, j, SLOT_LD, SLOT_WR) do { \
            SBAR(); { const int jl_ = ((j) + 2 < NT) ? (j) + 2 : NT - 1; SLOAD(SLOT_LD, jl_); } \
            qkt<DQK>(PC0, PC1, K_lds + bc * CF::SHM_K, qr, r32, hi); \
            if constexpr (NCB == 2) { exp8<0>(PP1, PSP); exp8<8>(PP1, PSP); } \
            lsum(PSP, l_reg); packp(PP0, PP1, pa0, pa1, pa2, pa3); SBAR(); \
            MK(PC0, PC1, (j)); PSC = 0.f; \
            pvf_one<NCB, 0>(o[0], vb0 + bp * CF::SHM_V, pa0, pa1, pa2, pa3); exp8<0>(PC0, PSC); asm volatile("" : "+v"(PC0), "+v"(PSC)); SBAR(); \
            SWAIT(); SWRITE(bn, SLOT_WR);                       \
            pvf_one<NCB, 1>(o[1], vb0 + bp * CF::SHM_V, pa0, pa1, pa2, pa3); exp8<8>(PC0, PSC); asm volatile("" : "+v"(PC0), "+v"(PSC)); SBAR(); \
            if constexpr (NCB == 4) { \
                pvf_one<NCB, 2>(o[2], vb0 + bp * CF::SHM_V, pa0, pa1, pa2, pa3); exp8<0>(PC1, PSC); asm volatile("" : "+v"(PC1), "+v"(PSC)); SBAR(); \
                pvf_one<NCB, 3>(o[3], vb0 + bp * CF::SHM_V, pa0, pa1, pa2, pa3); exp8<8>(PC1, PSC); asm volatile("" : "+v"(PC1), "+v"(PSC)); SBAR(); } \
            __syncthreads(); ROT3(); } while (0)
        for (int j = 1; j + 1 < NT; j += 2) {
            FSTEP(pB0, pB1, pA0, pA1, psB, psA, j, SO, SE);
            FSTEP(pA0, pA1, pB0, pB1, psA, psB, j + 1, SE, SO);
        }
        SBAR(); qkt<DQK>(pB0, pB1, K_lds + bc * CF::SHM_K, qr, r32, hi);
        if constexpr (NCB == 2) { exp8<0>(pA1, psA); exp8<8>(pA1, psA); }
        lsum(psA, l_reg); packp(pA0, pA1, pa0, pa1, pa2, pa3); SBAR();
        MK(pB0, pB1, NT - 1); psB = 0.f; pv_exp<NCB>(o, vb0 + bp * CF::SHM_V, pa0, pa1, pa2, pa3, pB0, pB1, psB);
        if constexpr (NCB == 2) { exp8<0>(pB1, psB); exp8<8>(pB1, psB); }
        lsum(psB, l_reg); packp(pB0, pB1, pa0, pa1, pa2, pa3); SBAR();
        pvf_all<NCB>(o, vb0 + bc * CF::SHM_V, pa0, pa1, pa2, pa3);
#undef FSTEP
    } else {
    qkt<DQK>(pA0, pA1, K_lds, qr, r32, hi); MK(pA0, pA1, 0); partialSM(pA0, pA1, m_reg, mnA, alA, THRL, fast);
    SLOAD(SO, 1); if (2 < NT) SLOAD(SE, 2);
    SWAIT(); SWRITE(1, SO); __syncthreads();
#define STEP(PC0, PC1, MNC, ALC, PP0, PP1, ALP, j, SLOT_LD, SLOT_WR, DO_LD, DO_WR) do { \
        SBAR(); qkt<DQK>(PC0, PC1, K_lds + bc * CF::SHM_K, qr, r32, hi); MK(PC0, PC1, (j)); \
        finishSM(PP0, PP1, ALP, l_reg, pa0, pa1, pa2, pa3); SBAR(); \
        if (DO_LD) SLOAD(SLOT_LD, (j) + 2); SBAR(); \
        pv_all<NCB>(o, vb0 + bp * CF::SHM_V, pa0, pa1, pa2, pa3); partialSM(PC0, PC1, m_reg, MNC, ALC, THRL, fast); \
        if (DO_WR) { SWAIT(); SWRITE(bn, SLOT_WR); } \
        RESC(ALC); __syncthreads(); ROT3(); } while (0)
    for (int j = 1; j + 1 < NT; j += 2) {
        STEP(pB0, pB1, mnB, alB, pA0, pA1, alA, j, SO, SE, true, true);
        STEP(pA0, pA1, mnA, alA, pB0, pB1, alB, j + 1, SE, SO, (j + 3 < NT), true);
    }
    SBAR(); qkt<DQK>(pB0, pB1, K_lds + bc * CF::SHM_K, qr, r32, hi); MK(pB0, pB1, NT - 1);
    finishSM(pA0, pA1, alA, l_reg, pa0, pa1, pa2, pa3); SBAR();
    pv_all<NCB>(o, vb0 + bp * CF::SHM_V, pa0, pa1, pa2, pa3); partialSM(pB0, pB1, m_reg, mnB, alB, THRL, fast);
    RESC(alB);
    finishSM(pB0, pB1, alB, l_reg, pa0, pa1, pa2, pa3); SBAR();
    pv_all<NCB>(o, vb0 + bc * CF::SHM_V, pa0, pa1, pa2, pa3);
    }
#undef STEP
#undef ROT3
    if (hi == 0) li_l[r32] = l_reg; asm volatile("s_waitcnt lgkmcnt(0)" ::: "memory");
    float rli[16];
#pragma unroll
    for (int r = 0; r < 16; ++r) rli[r] = __builtin_amdgcn_rcpf(li_l[crow(r, hi)]);
    EP(o, rli, wid, r32, hi);
    __syncthreads();
#undef SLOAD
#undef SWRITE
#undef SWAIT
#undef RESC
}
struct DenseMap { __device__ __forceinline__ long operator()(int j) const { return (long)j * KVBLK; } };
struct NoMask { __device__ __forceinline__ void operator()(f32x16&, f32x16&, int) const {} };
}


struct Frame {
    LAS unsigned char* lds; unsigned char* ldsg;
    volatile LAS unsigned* MISC;
    unsigned char* ws;
    int tid, lane, wave, G, vcu;
    float* out;
};
#ifndef MK_REPEAT
#define MK_REPEAT -1
#endif
struct Args { const float* in[32]; float* out; unsigned char* ws; int ph_lo, ph_hi; };
#define AIN(i) (A_.in[i])
#define FW(off, T) ((T*)(F.ws + (off)))
__device__ __forceinline__ i64* mod_ptr(const Frame& F, int layer) { return (i64*)(F.ws + CTL_MOD_OFF) + (size_t)layer * 5 * 6144; }

template <class RowMap>
__device__ __forceinline__ void transpose_item(const float* W, int N, bf16_t* WT, int ldk, const RowMap& rowmap, LAS float* scr, int item, int lane) {
    const int nblk = N / 32, kb = item / nblk, nb = item - kb * nblk, k0 = 64 * kb, n0 = 32 * nb;
#pragma unroll 8
    for (int i = 0; i < 32; ++i) { const int kk = 2 * i + (lane >> 5); scr[kk * 33 + (lane & 31)] = __builtin_nontemporal_load(&W[(size_t)(k0 + kk) * N + n0 + (lane & 31)]); }
    LDS_WAIT(); asm volatile("" ::: "memory");
    const int c = lane & 7;
#pragma unroll
    for (int j = 0; j < 4; ++j) { const int n = (lane >> 3) + 8 * j; const LAS float* s = scr + (8 * c) * 33 + n;
        v4u o; o.x = pk2(s[0 * 33], s[1 * 33]); o.y = pk2(s[2 * 33], s[3 * 33]); o.z = pk2(s[4 * 33], s[5 * 33]); o.w = pk2(s[6 * 33], s[7 * 33]);
        __builtin_nontemporal_store(o, (GAS v4u*)(WT + (size_t)rowmap(n0 + n) * ldk + k0 + 8 * c)); }
    LDS_WAIT(); asm volatile("" ::: "memory");
}
struct MapPlain { int off; __device__ __forceinline__ int operator()(int n) const { return off + n; } };
struct MapQKVRope { __device__ __forceinline__ int operator()(int n) const {
    const int sec = n >> 10, cc = n & 1023; if (sec == 2) return n; const int sh = cc >> 6, d = cc & 63; return sec * 1024 + (sh >> 2) * 256 + (d >> 5) * 128 + (sh & 3) * 32 + (d & 31); } };
struct MapMlaUq { __device__ __forceinline__ int operator()(int n) const {
    const int h = n / 96, d = n - h * 96; if (d < 64) return h * 64 + d; const int j = d - 64, e = j >> 4, f = j & 15; return 1024 + (h >> 3) * 256 + e * 128 + (h & 7) * 16 + f; } };
struct MapGateUp { int up; __device__ __forceinline__ int operator()(int f) const { return (f >> 7) * 256 + up * 128 + (f & 127); } };

__device__ __forceinline__ void conv_moe_item(const Frame& F, const Args& A_, int layer, int it, LAS float* scr) {
    constexpr int I_EXP = 16 * 64; const int e = it / (3 * I_EXP), q = it - e * 3 * I_EXP, which = q / I_EXP, item = q - which * I_EXP; const size_t le = (size_t)layer * NEXP + e;
    if (which == 0) transpose_item(AIN(29) + le * 1024 * 2048, 2048, FW(WS_WGU, bf16_t) + le * 4096 * 1024, 1024, MapGateUp{0}, scr, item, F.lane);
    else if (which == 1) transpose_item(AIN(30) + le * 1024 * 2048, 2048, FW(WS_WGU, bf16_t) + le * 4096 * 1024, 1024, MapGateUp{1}, scr, item, F.lane);
    else transpose_item(AIN(31) + le * 2048 * 1024, 1024, FW(WS_WDN, bf16_t) + le * 1024 * 2048, 2048, MapPlain{0}, scr, item, F.lane);
}
__device__ __forceinline__ void conv_filler(Frame& F0, const Args& A_, int l0, int quota) {
    Frame F = F0; { int t_ = (int)threadIdx.x; asm volatile("" : "+v"(t_)); F.tid = t_; F.lane = t_ & 63; }
    LAS float* scr = (LAS float*)(F.lds + RING_OFF + F.wave * 16384);
    unsigned* qh = (unsigned*)(F.ws + WS_CTL) + CW_Q;
    int l = l0;
    for (int n = 0; n < quota && l < DEPTH; ) {
        unsigned base = 0; if (F.lane == 0) base = __hip_atomic_fetch_add(qh + 64 * l, 4u, __ATOMIC_RELAXED, __HIP_MEMORY_SCOPE_AGENT);
        base = (unsigned)__builtin_amdgcn_readfirstlane((int)base);
        if (base >= (unsigned)CONV_ITEMS) { ++l; continue; }
#pragma unroll 1
        for (int k = 0; k < 4; ++k) conv_moe_item(F, A_, l, (int)base + k, scr);
        ++n;
    }
}
__device__ __forceinline__ void conv_filler_layer(Frame& F0, const Args& A_, int l) {
    Frame F = F0; { int t_ = (int)threadIdx.x; asm volatile("" : "+v"(t_)); F.tid = t_; F.lane = t_ & 63; }
    LAS float* scr = (LAS float*)(F.lds + RING_OFF + F.wave * 16384);
    unsigned* qh = (unsigned*)(F.ws + WS_CTL) + CW_Q;
    __syncthreads();
    for (;;) {
        unsigned base = 0; if (F.lane == 0) base = __hip_atomic_fetch_add(qh + 64 * l, 4u, __ATOMIC_RELAXED, __HIP_MEMORY_SCOPE_AGENT);
        base = (unsigned)__builtin_amdgcn_readfirstlane((int)base);
        if (base >= (unsigned)CONV_ITEMS) break;
#pragma unroll 1
        for (int k = 0; k < 4; ++k) conv_moe_item(F, A_, l, (int)base + k, scr);
    }
}
__device__ __forceinline__ void p_prologue(Frame& F0, const Args& A_) {
    Frame F = F0; { int t_ = (int)threadIdx.x; asm volatile("" : "+v"(t_)); F.tid = t_; F.lane = t_ & 63; }
    LAS float* scr = (LAS float*)(F.lds + RING_OFF + F.wave * 16384);
    const int gw = F.vcu * NWAVES + F.wave, NGW = F.G * NWAVES;
    { const float* c = AIN(1); const float* cctx = AIN(3); const float* aw = AIN(4); const float* ab = AIN(5);
      for (int t = gw; t < 4 * 16 * 24; t += NGW) { const int l = t / 384, r = t - l * 384, kc = r / 24, cc = r - kc * 24; const int col = cc * 256 + 4 * F.lane;
          f32x4 acc[5];
#pragma unroll
          for (int j = 0; j < 5; ++j) acc[j] = (f32x4){0.f, 0.f, 0.f, 0.f};
          const float* wp = aw + ((size_t)l * 1024 + kc * 64) * 6144 + col;
#pragma unroll 16
          for (int kk = 0; kk < 64; ++kk) { const int k = kc * 64 + kk; const f32x4 w = *(const f32x4*)(wp + (size_t)kk * 6144);
#pragma unroll
              for (int j = 0; j < 5; ++j) { const float v = (j < 4) ? c[j * 1024 + k] : cctx[k]; const float s = v / (1.f + __expf(-v)); acc[j] += w * s; } }
          if (kc == 0) { const f32x4 bv = *(const f32x4*)(ab + (size_t)l * 6144 + col);
#pragma unroll
              for (int j = 0; j < 5; ++j) acc[j] += bv; }
          i64* mp = mod_ptr(F, l) + col;
#pragma unroll
          for (int j = 0; j < 5; ++j)
#pragma unroll
              for (int i = 0; i < 4; ++i) __hip_atomic_fetch_add(mp + j * 6144 + i, (i64)(acc[j][i] * MOD_SC), __ATOMIC_RELAXED, __HIP_MEMORY_SCOPE_AGENT);
      } }
    { float* tab = FW(WS_TAB, float); const int gt_ = blockIdx.x * NTHR + F.tid, NT_ = F.G * NTHR;
        for (int i = gt_; i < 192 * 16; i += NT_) { const int p = i >> 4, f = i & 15; const float pos = (float)(p < 128 ? p : p - 128); const float ang = pos * __powf(10000.f, -(float)f / 16.f);
            tab[TAB_COS64 + i] = cosf(ang); tab[TAB_SIN64 + i] = sinf(ang); }
        for (int i = gt_; i < 192 * 8; i += NT_) { const int p = i >> 3, f = i & 7; const float pos = (float)(p < 128 ? p : p - 128); const float ang = pos * __powf(10000.f, -(float)f / 8.f);
            tab[TAB_COS32 + i] = cosf(ang); tab[TAB_SIN32 + i] = sinf(ang); }
        if (blockIdx.x == 0 && F.wave == 0) { const float a = wave_sum(AIN(11)[F.lane] * AIN(12)[F.lane]), b = wave_sum(AIN(13)[F.lane] * AIN(14)[F.lane]);
            if (F.lane == 0) tab[TAB_LAM] = (expf(a) - expf(b)) + 0.2f; } }
    { v4u* z = (v4u*)(FW(W_MLA_DQKV, bf16_t) + 1056 * 1024); const v4u zz = {0u, 0u, 0u, 0u};
      for (int i = blockIdx.x * NTHR + F.tid; i < 224 * 1024 / 8; i += F.G * NTHR) z[i] = zz; }
    for (int t = blockIdx.x; t < 256; t += F.G) { const int g = t >> 6, cc = (t >> 1) & 31, half = t & 1; const float* wo = AIN(16);
        LAS float* Ws = (LAS float*)(F.lds + RING_OFF); LAS float* ct = Ws + 256 * 33; LAS float* st = ct + 256;
        __syncthreads();
        for (int i = F.tid; i < 256 * 32; i += NTHR) { const int j = i >> 5, c = i & 31; Ws[j * 33 + c] = wo[(size_t)(g * 256 + j) * 1024 + cc * 32 + c]; }
        if (F.tid < 256) { ct[F.tid] = __builtin_amdgcn_cosf((float)F.tid * (1.f / 256.f)); st[F.tid] = __builtin_amdgcn_sinf((float)F.tid * (1.f / 256.f)); }
        __syncthreads();
        const int cl = F.tid & 31, kb = F.tid >> 5;
        bf16_t* wfn = FW(W_FN, bf16_t);
        for (int i = 0; i < 5; ++i) { const int kl = kb + 16 * (half * 4 + i); if (i == 4 && !(half == 1 && kb == 0)) break;
            float sc = 0.f, ss = 0.f;
            for (int j = 0; j < 256; ++j) { const float w = Ws[j * 33 + cl]; const int ix = (kl * j) & 255; sc += w * ct[ix]; ss += w * st[ix]; }
            const float scale = 0.0625f;
            wfn[(size_t)(cc * 32 + cl) * 1024 + g * 256 + kl] = (bf16_t)f2bf(sc * scale);
            wfn[(size_t)(1024 + cc * 32 + cl) * 1024 + g * 256 + kl] = (bf16_t)f2bf(ss * scale);
            if (kl >= 1 && kl <= 127) { wfn[(size_t)(cc * 32 + cl) * 1024 + g * 256 + (256 - kl)] = (bf16_t)f2bf(sc * scale);
                wfn[(size_t)(1024 + cc * 32 + cl) * 1024 + g * 256 + (256 - kl)] = (bf16_t)f2bf(-ss * scale); } }
    }
    __syncthreads();
    constexpr int I_QKV = 16 * 96, I_O = 16 * 32, I_DQ = 16 * 24, I_DKV = 16 * 9, I_UQ = 12 * 48, I_UK = 4 * 32;
    constexpr int I_SMALL = 2 * I_QKV + 3 * I_O + I_DQ + I_DKV + I_UQ + 2 * I_UK;
    constexpr int I_MOE = DEPTH * CONV_ITEMS;
    for (int it = gw; it < I_SMALL + I_MOE; it += NGW) {
        int r = it;
        if (r >= I_SMALL) { r -= I_SMALL; const int ly = r / CONV_ITEMS; conv_moe_item(F, A_, ly, r - ly * CONV_ITEMS, scr); continue; }
        if (r < I_QKV) { transpose_item(AIN(9), 3072, FW(W_DA_QKV, bf16_t), 1024, MapQKVRope{}, scr, r, F.lane); continue; } r -= I_QKV;
        if (r < I_O) { transpose_item(AIN(10), 1024, FW(W_DA_O, bf16_t), 1024, MapPlain{0}, scr, r, F.lane); continue; } r -= I_O;
        if (r < I_QKV) { transpose_item(AIN(17), 3072, FW(W_NA_QKV, bf16_t), 1024, MapPlain{0}, scr, r, F.lane); continue; } r -= I_QKV;
        if (r < I_O) { transpose_item(AIN(18), 1024, FW(W_NA_O, bf16_t), 1024, MapPlain{0}, scr, r, F.lane); continue; } r -= I_O;
        if (r < I_DQ) { transpose_item(AIN(20), 768, FW(W_MLA_DQKV, bf16_t), 1024, MapPlain{0}, scr, r, F.lane); continue; } r -= I_DQ;
        if (r < I_DKV) { transpose_item(AIN(23), 288, FW(W_MLA_DQKV, bf16_t), 1024, MapPlain{768}, scr, r, F.lane); continue; } r -= I_DKV;
        if (r < I_UQ) { transpose_item(AIN(22), 1536, FW(W_MLA_UQ, bf16_t), 768, MapMlaUq{}, scr, r, F.lane); continue; } r -= I_UQ;
        if (r < I_UK) { transpose_item(AIN(25), 1024, FW(W_MLA_UKV, bf16_t), 256, MapPlain{0}, scr, r, F.lane); continue; } r -= I_UK;
        if (r < I_UK) { transpose_item(AIN(26), 1024, FW(W_MLA_UKV, bf16_t), 256, MapPlain{1024}, scr, r, F.lane); continue; } r -= I_UK;
        transpose_item(AIN(27), 1024, FW(W_MLA_O, bf16_t), 1024, MapPlain{0}, scr, r, F.lane);
    }
}

__device__ __forceinline__ void load_row_x(const Frame& F, int row, int layer, f32x4 (&v)[4], const Args& A_) {
    if (layer == 0) { const int b = row / NTB, t = row - b * NTB; const float* src = (t < CTXL) ? AIN(2) + ((size_t)b * CTXL + t) * DM : AIN(0) + ((size_t)b * SEQ + (t - CTXL)) * DM;
#pragma unroll
        for (int j = 0; j < 4; ++j) v[j] = *(const f32x4*)(src + 4 * F.lane + 256 * j);
    } else { const xres_t* src = FW(WS_X, xres_t) + (size_t)row * DM;
#pragma unroll
        for (int j = 0; j < 4; ++j) v[j] = ldx4(src + 4 * F.lane + 256 * j); }
}
__device__ __forceinline__ int load_tokslot(const Frame& F, int row) { return FW(WS_TOKSLOT, int)[(size_t)row * 16 + (F.lane & 15)]; }
__device__ __forceinline__ void moe_combine(const Frame& F, int row, int pl, int myslot, f32x4 (&v)[4]) {
    f32x4 a[4];
#pragma unroll
    for (int j = 0; j < 4; ++j) a[j] = (f32x4){0.f, 0.f, 0.f, 0.f};
    if ((row % NTB) < CTXL) {
        const float* YC = FW(WS_YC, float) + 4 * F.lane; unsigned balc = (unsigned)(__ballot(myslot >= 0) & 0xffffull);
        while (balc) { const int e0 = __builtin_ctz(balc); balc &= balc - 1; const int s0 = __shfl(myslot, e0); const int ee = s0 / SLOTS_E, idx = ee * 128 + (s0 - ee * SLOTS_E - 4096);
#pragma unroll
            for (int kq = 0; kq < 4; ++kq)
#pragma unroll
                for (int j = 0; j < 4; ++j) a[j] += *(const f32x4*)(YC + ((size_t)kq * (NEXP * 128) + idx) * DM + 256 * j); }
        const i64* g2c = mod_ptr(F, pl) + (size_t)4 * 6144 + 5 * 1024 + 4 * F.lane;
#pragma unroll
        for (int j = 0; j < 4; ++j) v[j] += ldmod4(g2c + 256 * j) * a[j];
        return;
    }
    const bf16_t* Y = FW(WS_Y, bf16_t) + 4 * F.lane;
    unsigned bal = (unsigned)(__ballot(myslot >= 0) & 0xffffull);
    while (bal) {
        const int e0 = __builtin_ctz(bal); bal &= bal - 1; const int s0 = __shfl(myslot, e0);
        int s1 = -1; if (bal) { const int e1 = __builtin_ctz(bal); bal &= bal - 1; s1 = __shfl(myslot, e1); }
        v2u w0[4], w1[4];
#pragma unroll
        for (int j = 0; j < 4; ++j) w0[j] = __builtin_nontemporal_load((const v2u*)(Y + (size_t)s0 * DM + 256 * j));
        if (s1 >= 0) {
#pragma unroll
            for (int j = 0; j < 4; ++j) w1[j] = __builtin_nontemporal_load((const v2u*)(Y + (size_t)s1 * DM + 256 * j));
        } else {
#pragma unroll
            for (int j = 0; j < 4; ++j) w1[j] = (v2u){0u, 0u};
        }
#pragma unroll
        for (int j = 0; j < 4; ++j) {
            a[j][0] += __builtin_bit_cast(float, w0[j].x << 16); a[j][1] += __builtin_bit_cast(float, w0[j].x & 0xffff0000u);
            a[j][2] += __builtin_bit_cast(float, w0[j].y << 16); a[j][3] += __builtin_bit_cast(float, w0[j].y & 0xffff0000u);
            a[j][0] += __builtin_bit_cast(float, w1[j].x << 16); a[j][1] += __builtin_bit_cast(float, w1[j].x & 0xffff0000u);
            a[j][2] += __builtin_bit_cast(float, w1[j].y << 16); a[j][3] += __builtin_bit_cast(float, w1[j].y & 0xffff0000u); }
    }
    const i64* g2 = mod_ptr(F, pl) + (size_t)midx_of_row(row) * 6144 + 5 * 1024 + 4 * F.lane;
#pragma unroll
    for (int j = 0; j < 4; ++j) v[j] += ldmod4(g2 + 256 * j) * a[j];
}
struct RowIn { xraw_t x[4]; int slot; };
__device__ __forceinline__ void row_issue(const Frame& F, int row, RowIn& r) {
    const xres_t* src = FW(WS_X, xres_t) + (size_t)row * DM + 4 * F.lane;
#pragma unroll
    for (int j = 0; j < 4; ++j) r.x[j] = ldxr(src + 256 * j);
    r.slot = load_tokslot(F, row);
}
struct YPre { v2u w0[4], w1[4]; unsigned rest; int n; };
__device__ __forceinline__ void y_issue(const Frame& F, int row, int myslot, YPre& y) {
    unsigned bal = (unsigned)(__ballot(myslot >= 0) & 0xffffull); y.n = 0;
#pragma unroll
    for (int j = 0; j < 4; ++j) { y.w0[j] = (v2u){0u, 0u}; y.w1[j] = (v2u){0u, 0u}; }
    if ((row % NTB) < CTXL) { y.rest = bal; return; }
    const bf16_t* Y = FW(WS_Y, bf16_t) + 4 * F.lane;
    if (bal) { const int e0 = __builtin_ctz(bal); bal &= bal - 1; const int s0 = __shfl(myslot, e0); y.n = 1;
#pragma unroll
        for (int j = 0; j < 4; ++j) y.w0[j] = __builtin_nontemporal_load((const v2u*)(Y + (size_t)s0 * DM + 256 * j));
        if (bal) { const int e1 = __builtin_ctz(bal); bal &= bal - 1; const int s1 = __shfl(myslot, e1); y.n = 2;
#pragma unroll
            for (int j = 0; j < 4; ++j) y.w1[j] = __builtin_nontemporal_load((const v2u*)(Y + (size_t)s1 * DM + 256 * j)); } }
    y.rest = bal;
}
__device__ __forceinline__ void y_consume(const Frame& F, int myslot, YPre& y, f32x4 (&a)[4]) {
    const bf16_t* Y = FW(WS_Y, bf16_t) + 4 * F.lane;
#pragma unroll
    for (int j = 0; j < 4; ++j) a[j] = (f32x4){0.f, 0.f, 0.f, 0.f};
    unsigned bal = y.rest;
    for (;;) {
#pragma unroll
        for (int j = 0; j < 4; ++j) {
            a[j][0] += __builtin_bit_cast(float, y.w0[j].x << 16); a[j][1] += __builtin_bit_cast(float, y.w0[j].x & 0xffff0000u);
            a[j][2] += __builtin_bit_cast(float, y.w0[j].y << 16); a[j][3] += __builtin_bit_cast(float, y.w0[j].y & 0xffff0000u);
            a[j][0] += __builtin_bit_cast(float, y.w1[j].x << 16); a[j][1] += __builtin_bit_cast(float, y.w1[j].x & 0xffff0000u);
            a[j][2] += __builtin_bit_cast(float, y.w1[j].y << 16); a[j][3] += __builtin_bit_cast(float, y.w1[j].y & 0xffff0000u); }
        if (!bal) break;
        const int e0 = __builtin_ctz(bal); bal &= bal - 1; const int s0 = __shfl(myslot, e0);
        int s1 = -1; if (bal) { const int e1 = __builtin_ctz(bal); bal &= bal - 1; s1 = __shfl(myslot, e1); }
#pragma unroll
        for (int j = 0; j < 4; ++j) y.w0[j] = __builtin_nontemporal_load((const v2u*)(Y + (size_t)s0 * DM + 256 * j));
        if (s1 >= 0) {
#pragma unroll
            for (int j = 0; j < 4; ++j) y.w1[j] = __builtin_nontemporal_load((const v2u*)(Y + (size_t)s1 * DM + 256 * j));
        } else {
#pragma unroll
            for (int j = 0; j < 4; ++j) y.w1[j] = (v2u){0u, 0u};
        }
    }
}
__device__ __forceinline__ void combine_row(const Frame& F, int row, int pl, const RowIn& c, YPre& y, f32x4 (&v)[4], int& cm, f32x4 (&g2c)[4]) {
#pragma unroll
    for (int j = 0; j < 4; ++j) v[j] = xexp(c.x[j]);
    if ((row % NTB) < CTXL) { moe_combine(F, row, pl, c.slot, v); return; }
    const int mi = midx_of_row(row);
    if (mi != cm) { cm = mi; const i64* g2 = mod_ptr(F, pl) + (size_t)mi * 6144 + 5 * 1024 + 4 * F.lane;
#pragma unroll
        for (int j = 0; j < 4; ++j) g2c[j] = ldmod4(g2 + 256 * j); }
    f32x4 a[4]; y_consume(F, c.slot, y, a);
#pragma unroll
    for (int j = 0; j < 4; ++j) v[j] += g2c[j] * a[j];
}
__device__ __forceinline__ void p_norm1_mlp(Frame& F0, int layer, const Args& A_) {
    Frame F = F0; { int t_ = (int)threadIdx.x; asm volatile("" : "+v"(t_)); F.tid = t_; F.lane = t_ & 63; }
    const int gw = F.vcu * NWAVES + F.wave, NGW = F.G * NWAVES;
    f32x4 gn[4];
#pragma unroll
    for (int j = 0; j < 4; ++j) gn[j] = *(const f32x4*)(AIN(6) + (size_t)layer * DM + 4 * F.lane + 256 * j);
    int cm = -1, cm2 = -1; f32x4 g2c[4], shc[4], scc[4];
    RowIn nA, nB; int rA = gw, rB = gw + NGW;
    if (rA < MALL) row_issue(F, rA, nA); if (rB < MALL) row_issue(F, rB, nB);
    while (rA < MALL) {
        const bool hasB = rB < MALL; const RowIn cA = nA, cB = nB; const int rA2 = rA + 2 * NGW, rB2 = rB + 2 * NGW;
        YPre yA, yB; y_issue(F, rA, cA.slot, yA); if (hasB) y_issue(F, rB, cB.slot, yB);
        if (rA2 < MALL) row_issue(F, rA2, nA); if (rB2 < MALL) row_issue(F, rB2, nB);
#pragma unroll 1
        for (int h = 0; h < 2; ++h) { if (h == 1 && !hasB) break;
            const int row = h ? rB : rA; f32x4 v[4];
            if (h == 0) combine_row(F, row, layer - 1, cA, yA, v, cm, g2c); else combine_row(F, row, layer - 1, cB, yB, v, cm, g2c);
            xres_t* xr = FW(WS_X, xres_t) + (size_t)row * DM + 4 * F.lane;
#pragma unroll
            for (int j = 0; j < 4; ++j) stx4(xr + 256 * j, v[j]);
            const int mi = midx_of_row(row);
            if (mi != cm2) { cm2 = mi; const i64* mp = mod_ptr(F, layer) + (size_t)mi * 6144 + 4 * F.lane;
#pragma unroll
                for (int j = 0; j < 4; ++j) { shc[j] = ldmod4(mp + 256 * j); scc[j] = ldmod4(mp + 1024 + 256 * j) + 1.f; } }
            float s = 0.f;
#pragma unroll
            for (int j = 0; j < 4; ++j) s += (v[j][0] * v[j][0] + v[j][1] * v[j][1]) + (v[j][2] * v[j][2] + v[j][3] * v[j][3]);
            const float rstd = 1.f / sqrtf(wave_sum(s) * (1.f / DM) + NORM_EPS);
            bf16_t* hr = FW(WS_H, bf16_t) + (size_t)row * DM + 4 * F.lane;
#pragma unroll
            for (int j = 0; j < 4; ++j) { const f32x4 hh = v[j] * rstd * gn[j] * scc[j] + shc[j]; v2u w; w.x = pk2(hh[0], hh[1]); w.y = pk2(hh[2], hh[3]); *(v2u*)(hr + 256 * j) = w; }
        }
        rA = rA2; rB = rB2;
    }
}
__device__ __forceinline__ void p_norm1_l0(Frame& F0, const Args& A_) {
    Frame F = F0; { int t_ = (int)threadIdx.x; asm volatile("" : "+v"(t_)); F.tid = t_; F.lane = t_ & 63; }
    const int gw = F.vcu * NWAVES + F.wave, NGW = F.G * NWAVES;
    f32x4 gn[4];
#pragma unroll
    for (int j = 0; j < 4; ++j) gn[j] = *(const f32x4*)(AIN(6) + 4 * F.lane + 256 * j);
    int cm2 = -1; f32x4 shc[4], scc[4];
    f32x4 nA[4], nB[4]; int rA = gw, rB = gw + NGW;
    if (rA < MALL) load_row_x(F, rA, 0, nA, A_); if (rB < MALL) load_row_x(F, rB, 0, nB, A_);
    while (rA < MALL) {
        const bool hasB = rB < MALL; f32x4 cA[4], cB[4]; const int rA2 = rA + 2 * NGW, rB2 = rB + 2 * NGW;
#pragma unroll
        for (int j = 0; j < 4; ++j) { cA[j] = nA[j]; cB[j] = nB[j]; }
        if (rA2 < MALL) load_row_x(F, rA2, 0, nA, A_); if (rB2 < MALL) load_row_x(F, rB2, 0, nB, A_);
#pragma unroll 1
        for (int h = 0; h < 2; ++h) { if (h == 1 && !hasB) break;
            const int row = h ? rB : rA; f32x4 v[4];
#pragma unroll
            for (int j = 0; j < 4; ++j) v[j] = h ? cB[j] : cA[j];
            xres_t* xr = FW(WS_X, xres_t) + (size_t)row * DM + 4 * F.lane;
#pragma unroll
            for (int j = 0; j < 4; ++j) stx4(xr + 256 * j, v[j]);
            const int mi = midx_of_row(row);
            if (mi != cm2) { cm2 = mi; const i64* mp = mod_ptr(F, 0) + (size_t)mi * 6144 + 4 * F.lane;
#pragma unroll
                for (int j = 0; j < 4; ++j) { shc[j] = ldmod4(mp + 256 * j); scc[j] = ldmod4(mp + 1024 + 256 * j) + 1.f; } }
            float s = 0.f;
#pragma unroll
            for (int j = 0; j < 4; ++j) s += (v[j][0] * v[j][0] + v[j][1] * v[j][1]) + (v[j][2] * v[j][2] + v[j][3] * v[j][3]);
            const float rstd = 1.f / sqrtf(wave_sum(s) * (1.f / DM) + NORM_EPS);
            bf16_t* hr = FW(WS_H, bf16_t) + (size_t)row * DM + 4 * F.lane;
#pragma unroll
            for (int j = 0; j < 4; ++j) { const f32x4 hh = v[j] * rstd * gn[j] * scc[j] + shc[j]; v2u w; w.x = pk2(hh[0], hh[1]); w.y = pk2(hh[2], hh[3]); *(v2u*)(hr + 256 * j) = w; }
        }
        rA = rA2; rB = rB2;
    }
}
__device__ __forceinline__ void p_norm1(Frame& F0, int layer, bool combine, const Args& A_) {
    if (combine && layer > 0) { p_norm1_mlp(F0, layer, A_); return; }
    if (layer == 0) { p_norm1_l0(F0, A_); return; }
    Frame F = F0; { int t_ = (int)threadIdx.x; asm volatile("" : "+v"(t_)); F.tid = t_; F.lane = t_ & 63; }
    const int gw = F.vcu * NWAVES + F.wave, NGW = F.G * NWAVES;
    const float* gain = AIN(6) + (size_t)layer * DM;
    f32x4 vn[4]; int slotn = -1;
    if (gw < MALL) { load_row_x(F, gw, layer, vn, A_); if (combine) slotn = load_tokslot(F, gw); }
    for (int row = gw; row < MALL; row += NGW) {
        f32x4 v[4]; const int myslot = slotn;
#pragma unroll
        for (int j = 0; j < 4; ++j) v[j] = vn[j];
        if (row + NGW < MALL) { load_row_x(F, row + NGW, layer, vn, A_); if (combine) slotn = load_tokslot(F, row + NGW); }
        if (combine) moe_combine(F, row, layer - 1, myslot, v);
        if (layer == 0 || combine) { xres_t* xr = FW(WS_X, xres_t) + (size_t)row * DM + 4 * F.lane;
#pragma unroll
            for (int j = 0; j < 4; ++j) stx4(xr + 256 * j, v[j]); }
        float s = 0.f;
#pragma unroll
        for (int j = 0; j < 4; ++j) s += (v[j][0] * v[j][0] + v[j][1] * v[j][1]) + (v[j][2] * v[j][2] + v[j][3] * v[j][3]);
        const float rstd = 1.f / sqrtf(wave_sum(s) * (1.f / DM) + NORM_EPS);
        const i64* mp = mod_ptr(F, layer) + (size_t)midx_of_row(row) * 6144 + 4 * F.lane;
        bf16_t* hr = FW(WS_H, bf16_t) + (size_t)row * DM + 4 * F.lane;
#pragma unroll
        for (int j = 0; j < 4; ++j) { const f32x4 gn = *(const f32x4*)(gain + 4 * F.lane + 256 * j), sh = ldmod4(mp + 256 * j), sc = ldmod4(mp + 1024 + 256 * j);
            const f32x4 h = v[j] * rstd * gn * (sc + 1.f) + sh; v2u w; w.x = pk2(h[0], h[1]); w.y = pk2(h[2], h[3]); *(v2u*)(hr + 256 * j) = w; }
    }
}
__device__ __forceinline__ void p_norm2_router(Frame& F0, int layer, bool skip_ctx, const Args& A_) {
    Frame F = F0; { int t_ = (int)threadIdx.x; asm volatile("" : "+v"(t_)); F.tid = t_; F.lane = t_ & 63; }
    const int gw = F.vcu * NWAVES + F.wave, NGW = F.G * NWAVES;
    const float* gain = AIN(7) + (size_t)layer * DM; const float* wr = AIN(28) + (size_t)layer * DM * NEXP;
    constexpr int RP = 1032;
    LAS bf16_t* wtb = (LAS bf16_t*)(F.lds + RING_OFF); LAS bf16_t* ht = wtb + 16 * RP + F.wave * (4 * RP);
    constexpr int NG = MALL / 4; const int full = NG / NGW, rem = NG - full * NGW, xid = F.wave * F.G + F.vcu;
    auto grp_at = [&](int i) { return i < full ? gw + i * NGW : ((i == full && xid < rem) ? full * NGW + xid : -1); };
    xraw_t vnx[4][4];
    int gi = 0, grp = grp_at(0), gnext = -1;
    if (grp >= 0) {
#pragma unroll
        for (int r = 0; r < 4; ++r)
#pragma unroll
            for (int j = 0; j < 4; ++j) vnx[r][j] = ldxr(FW(WS_X, xres_t) + (size_t)(grp * 4 + r) * DM + 4 * F.lane + 256 * j); }
    __syncthreads();
    for (int i = F.tid; i < DM * NEXP; i += NTHR) { const int k = i >> 4, e = i & 15; wtb[e * RP + k] = (bf16_t)f2bf(wr[i]); }
    __syncthreads();
    for (; grp >= 0; grp = gnext, ++gi) {
        const int row0 = grp * 4; const int b = row0 / NTB, t0 = row0 - b * NTB;
        f32x4 v[4][4]; float rstd[4];
#pragma unroll
        for (int r = 0; r < 4; ++r)
#pragma unroll
            for (int j = 0; j < 4; ++j) v[r][j] = xexp(vnx[r][j]);
        gnext = grp_at(gi + 1);
        if (gnext >= 0) {
#pragma unroll
            for (int r = 0; r < 4; ++r)
#pragma unroll
                for (int j = 0; j < 4; ++j) vnx[r][j] = ldxr(FW(WS_X, xres_t) + (size_t)(gnext * 4 + r) * DM + 4 * F.lane + 256 * j); }
        if (skip_ctx && t0 < CTXL) continue;
        const i64* mp = mod_ptr(F, layer) + (size_t)(t0 < CTXL ? 4 : b) * 6144 + 3 * 1024 + 4 * F.lane;
#pragma unroll
        for (int r = 0; r < 4; ++r) { float s = 0.f;
#pragma unroll
            for (int j = 0; j < 4; ++j) s += (v[r][j][0] * v[r][j][0] + v[r][j][1] * v[r][j][1]) + (v[r][j][2] * v[r][j][2] + v[r][j][3] * v[r][j][3]);
            rstd[r] = 1.f / sqrtf(wave_sum(s) * (1.f / DM) + NORM_EPS); }
#pragma unroll
        for (int j = 0; j < 4; ++j) { const f32x4 gn = *(const f32x4*)(gain + 4 * F.lane + 256 * j), sh = ldmod4(mp + 256 * j), sc = ldmod4(mp + 1024 + 256 * j);
#pragma unroll
            for (int r = 0; r < 4; ++r) { v[r][j] = v[r][j] * rstd[r] * gn * (sc + 1.f) + sh; v2u w; w.x = cvt_pk_bf16(v[r][j][0], v[r][j][1]); w.y = cvt_pk_bf16(v[r][j][2], v[r][j][3]);
                *(v2u*)(FW(WS_H, bf16_t) + (size_t)(row0 + r) * DM + 4 * F.lane + 256 * j) = w; *(LAS v2u*)(ht + r * RP + 4 * F.lane + 256 * j) = w; } }
        asm volatile("" ::: "memory");
        const int e_ = F.lane & 15, kg = F.lane >> 4; f32x4 lg = {0.f, 0.f, 0.f, 0.f}, lgb = {0.f, 0.f, 0.f, 0.f};
        { const LAS bf16_t* ap = wtb + e_ * RP + 8 * kg; const LAS bf16_t* bp = ht + (e_ & 3) * RP + 8 * kg;
#pragma unroll
          for (int m = 0; m < 32; m += 2) {
              const bf16x8 a0 = *(const LAS bf16x8*)(ap + 32 * m), b0 = *(const LAS bf16x8*)(bp + 32 * m), a1 = *(const LAS bf16x8*)(ap + 32 * m + 32), b1 = *(const LAS bf16x8*)(bp + 32 * m + 32);
              lg = __builtin_amdgcn_mfma_f32_16x16x32_bf16(a0, b0, lg, 0, 0, 0); lgb = __builtin_amdgcn_mfma_f32_16x16x32_bf16(a1, b1, lgb, 0, 0, 0); } }
        lg += lgb;
        float mx = fmaxf(fmaxf(lg[0], lg[1]), fmaxf(lg[2], lg[3])); mx = fmaxf(mx, __shfl_xor(mx, 16)); mx = fmaxf(mx, __shfl_xor(mx, 32));
        f32x4 ex; float den = 0.f;
#pragma unroll
        for (int i = 0; i < 4; ++i) { ex[i] = expf(lg[i] - mx); den += ex[i]; }
        den += __shfl_xor(den, 16); den += __shfl_xor(den, 32);
        if (e_ < 4) {
#pragma unroll
            for (int i = 0; i < 4; ++i) FW(WS_AFF, float)[((size_t)b * NEXP + 4 * kg + i) * NTB + t0 + e_] = ex[i] / den; }
        FW(WS_TOKSLOT, int)[(size_t)row0 * 16 + F.lane] = -1;
    }
    __syncthreads();
}
__device__ __forceinline__ void p_topk(Frame& F0, int ntask) {
    Frame F = F0; { int t_ = (int)threadIdx.x; asm volatile("" : "+v"(t_)); F.tid = t_; F.lane = t_ & 63; }
    LAS unsigned* key = (LAS unsigned*)(F.lds + RING_OFF);
    LAS unsigned* hist = key + 8192;
    LAS unsigned* wsum = hist + 256;
    LAS unsigned* sh = wsum + 16;
    int* IDX = FW(WS_IDX, int); float* GATE = FW(WS_GATE, float); int* TS = FW(WS_TOKSLOT, int);
    for (int task = blockIdx.x; task < ntask; task += F.G) {
        const int stream = task >> 6, b = (task >> 4) & 3, e = task & 15;
        const int n = stream ? CTXL : SEQ, k = n >> 3;
        const float* src = FW(WS_AFF, float) + ((size_t)b * NEXP + e) * NTB + (stream ? 0 : CTXL);
        __syncthreads();
        for (int i = F.tid; i < n; i += NTHR) key[i] = __builtin_bit_cast(unsigned, src[i]);
        unsigned prefix = 0u, krem = (unsigned)k;
        for (int pass = 3; pass >= 0; --pass) {
            if (F.tid < 256) hist[F.tid] = 0u;
            __syncthreads();
            const int shf = 8 * pass;
            for (int i = F.tid; i < n; i += NTHR) { const unsigned kv = key[i]; if (pass == 3 || (unsigned)((unsigned long long)kv >> (shf + 8)) == prefix) atomicAdd((unsigned*)&hist[(kv >> shf) & 255u], 1u); }
            __syncthreads();
            if (F.wave == 0) {
                const unsigned c0 = hist[4 * F.lane], c1 = hist[4 * F.lane + 1], c2 = hist[4 * F.lane + 2], c3 = hist[4 * F.lane + 3];
                const unsigned tot = c0 + c1 + c2 + c3; unsigned suf = tot;
#pragma unroll
                for (int o = 1; o < 64; o <<= 1) { const unsigned t2 = __shfl_down(suf, o); if (F.lane + o < 64) suf += t2; }
                const unsigned above = suf - tot;
                unsigned a3 = above, a2 = a3 + c3, a1 = a2 + c2, a0 = a1 + c1;
                if (a3 < krem && krem <= a3 + c3) { sh[0] = (prefix << 8) | (unsigned)(4 * F.lane + 3); sh[1] = krem - a3; }
                if (a2 < krem && krem <= a2 + c2) { sh[0] = (prefix << 8) | (unsigned)(4 * F.lane + 2); sh[1] = krem - a2; }
                if (a1 < krem && krem <= a1 + c1) { sh[0] = (prefix << 8) | (unsigned)(4 * F.lane + 1); sh[1] = krem - a1; }
                if (a0 < krem && krem <= a0 + c0) { sh[0] = (prefix << 8) | (unsigned)(4 * F.lane + 0); sh[1] = krem - a0; }
            }
            __syncthreads();
            prefix = sh[0]; krem = sh[1];
            __syncthreads();
        }
        const unsigned T = prefix; const int per = n / NTHR;
        const int i0 = stream ? F.tid : F.tid * per, cnt = stream ? (F.tid < n ? 1 : 0) : per;
        unsigned ngt = 0, neq = 0;
        for (int i = 0; i < cnt; ++i) { const unsigned kv = key[i0 + i]; ngt += kv > T; neq += kv == T; }
        unsigned packed = (neq << 16) | ngt, inc = packed;
#pragma unroll
        for (int o = 1; o < 64; o <<= 1) { const unsigned t2 = __shfl_up(inc, o); if (F.lane >= o) inc += t2; }
        if (F.lane == 63) wsum[F.wave] = inc;
        __syncthreads();
        unsigned base = 0, total = 0;
        for (int w = 0; w < NWAVES; ++w) { const unsigned x = wsum[w]; if (w < F.wave) base += x; total += x; }
        const unsigned excl = base + inc - packed; unsigned gpos = excl & 0xffffu, epos = excl >> 16; const unsigned ngt_tot = total & 0xffffu;
        const int slot0 = e * SLOTS_E + (stream ? 4 * CAP_L + b * CAP_C : b * CAP_L);
        const int rowbase = b * NTB + (stream ? 0 : CTXL);
        for (int i = 0; i < cnt; ++i) { const unsigned kv = key[i0 + i]; int slot = -1;
            if (kv > T) slot = (int)gpos++; else if (kv == T) { if (epos < krem) slot = (int)(ngt_tot + epos); ++epos; }
            if (slot >= 0) { const int sg = slot0 + slot, row = rowbase + i0 + i; IDX[sg] = row; GATE[sg] = __builtin_bit_cast(float, kv); TS[(size_t)row * 16 + e] = sg; } }
        if (stream == 1 && b == 0 && F.tid < 128) { IDX[e * SLOTS_E + 4224 + F.tid] = -1; GATE[e * SLOTS_E + 4224 + F.tid] = 0.f; }
    }
    __syncthreads();
}
__device__ __forceinline__ void p_final(Frame& F0, bool combine, const Args& A_) {
    Frame F = F0; { int t_ = (int)threadIdx.x; asm volatile("" : "+v"(t_)); F.tid = t_; F.lane = t_ & 63; }
    const int gw = F.vcu * NWAVES + F.wave, NGW = F.G * NWAVES; const float* gain = AIN(8);
    auto rowof = [](int r) { const int b = r / SEQ; return b * NTB + CTXL + (r - b * SEQ); };
    if (combine) {
        f32x4 gn[4];
#pragma unroll
        for (int j = 0; j < 4; ++j) gn[j] = *(const f32x4*)(gain + 4 * F.lane + 256 * j);
        int cm = -1; f32x4 g2c[4]; RowIn nA, nB; int rA = gw, rB = gw + NGW; constexpr int NR = NB * SEQ;
        if (rA < NR) row_issue(F, rowof(rA), nA); if (rB < NR) row_issue(F, rowof(rB), nB);
        while (rA < NR) {
            const bool hasB = rB < NR; const RowIn cA = nA, cB = nB; const int rA2 = rA + 2 * NGW, rB2 = rB + 2 * NGW;
            YPre yA, yB; y_issue(F, rowof(rA), cA.slot, yA); if (hasB) y_issue(F, rowof(rB), cB.slot, yB);
            if (rA2 < NR) row_issue(F, rowof(rA2), nA); if (rB2 < NR) row_issue(F, rowof(rB2), nB);
#pragma unroll 1
            for (int h = 0; h < 2; ++h) { if (h == 1 && !hasB) break;
                const int r = h ? rB : rA; f32x4 v[4];
                if (h == 0) combine_row(F, rowof(r), DEPTH - 1, cA, yA, v, cm, g2c); else combine_row(F, rowof(r), DEPTH - 1, cB, yB, v, cm, g2c);
                float s = 0.f;
#pragma unroll
                for (int j = 0; j < 4; ++j) s += (v[j][0] * v[j][0] + v[j][1] * v[j][1]) + (v[j][2] * v[j][2] + v[j][3] * v[j][3]);
                const float rstd = 1.f / sqrtf(wave_sum(s) * (1.f / DM) + NORM_EPS);
                float* orow = F.out + (size_t)r * DM + 4 * F.lane;
#pragma unroll
                for (int j = 0; j < 4; ++j) __builtin_nontemporal_store(v[j] * rstd * gn[j], (f32x4*)(orow + 256 * j));
            }
            rA = rA2; rB = rB2;
        }
        return;
    }
    f32x4 vn[4]; int slotn = -1;
    if (gw < NB * SEQ) { load_row_x(F, rowof(gw), 1, vn, A_); if (combine) slotn = load_tokslot(F, rowof(gw)); }
    for (int r = gw; r < NB * SEQ; r += NGW) { const int row = rowof(r);
        f32x4 v[4]; const int myslot = slotn;
#pragma unroll
        for (int j = 0; j < 4; ++j) v[j] = vn[j];
        if (r + NGW < NB * SEQ) { load_row_x(F, rowof(r + NGW), 1, vn, A_); if (combine) slotn = load_tokslot(F, rowof(r + NGW)); }
        if (combine) moe_combine(F, row, DEPTH - 1, myslot, v);
        float s = 0.f;
#pragma unroll
        for (int j = 0; j < 4; ++j) s += (v[j][0] * v[j][0] + v[j][1] * v[j][1]) + (v[j][2] * v[j][2] + v[j][3] * v[j][3]);
        const float rstd = 1.f / sqrtf(wave_sum(s) * (1.f / DM) + NORM_EPS);
        float* orow = F.out + (size_t)r * DM + 4 * F.lane;
#pragma unroll
        for (int j = 0; j < 4; ++j) *(f32x4*)(orow + 256 * j) = v[j] * rstd * *(const f32x4*)(gain + 4 * F.lane + 256 * j);
    }
}
__device__ __forceinline__ void p_dftgen(Frame& F0) {
    Frame F = F0; { int t_ = (int)threadIdx.x; asm volatile("" : "+v"(t_)); F.tid = t_; F.lane = t_ & 63; }
    const int gt = blockIdx.x * NTHR + F.tid, NT_ = F.G * NTHR;
    bf16_t* W2 = FW(WS_S + S_W2, bf16_t); bf16_t* W1B = FW(WS_S + S_W1B, bf16_t); bf16_t* DC = FW(WS_S + S_DFTC, bf16_t);
    for (int i = gt; i < 256 * 256; i += NT_) { const int r = i >> 8, cidx = i & 255; const int ri = r >> 7, k2 = r & 127, part = cidx >> 7, n2 = cidx & 127;
        const float rev = (float)((k2 * n2) & 127) * (1.f / 128.f); const float cs = __builtin_amdgcn_cosf(rev), sn = __builtin_amdgcn_sinf(rev);
        const float v = (ri == 0) ? (part == 0 ? cs : -sn) : (part == 0 ? sn : cs); W2[i] = (bf16_t)f2bf(v * 0.011048543456039806f); }
    for (int i = gt; i < 256 * 512; i += NT_) { const int r = i >> 9, cidx = i & 511; const int j = r >> 6, k1 = r & 63, jp = cidx >> 7, ri = (cidx >> 6) & 1, n1 = cidx & 63;
        const float rev = (float)((k1 * n1) & 63) * (1.f / 64.f); const float v = (j != jp) ? 0.f : (ri == 0 ? __builtin_amdgcn_cosf(rev) : -__builtin_amdgcn_sinf(rev)); W1B[i] = (bf16_t)f2bf(v); }
    for (int i = gt; i < 256 * 512; i += NT_) { const int k = i >> 9, cidx = i & 511; const int part = cidx >> 8, n = cidx & 255;
        const float rev = (float)((k * n) & 255) * (1.f / 256.f); const float v = part ? -__builtin_amdgcn_sinf(rev) : __builtin_amdgcn_cosf(rev); DC[i] = (bf16_t)f2bf(v * 0.0625f); }
}
__device__ __forceinline__ void p_mla_norm(Frame& F0, const Args& A_) {
    Frame F = F0; { int t_ = (int)threadIdx.x; asm volatile("" : "+v"(t_)); F.tid = t_; F.lane = t_ & 63; }
    const int gw = F.vcu * NWAVES + F.wave, NGW = F.G * NWAVES;
    const float* qg = AIN(21); const float* kg = AIN(24); const float* tab = FW(WS_TAB, float);
    unsigned* krmax = (unsigned*)(F.ws + WS_CTL) + CW_KMAX + 384; float kr_mx = 0.f; int kr_b = -1;
    v2u nA[5], nB[5]; int rA = gw, rB = gw + NGW;
    auto ld_row = [&](int row, v2u (&r)[5]) { const bf16_t* dr = FW(WS_S + S_DQ, bf16_t) + (size_t)row * 1280 + 4 * F.lane;
#pragma unroll
        for (int j = 0; j < 5; ++j) r[j] = *(const v2u*)(dr + 256 * j); };
    if (rA < MALL) ld_row(rA, nA); if (rB < MALL) ld_row(rB, nB);
    for (; rA < MALL; rA += 2 * NGW, rB += 2 * NGW) {
      const bool hasB = rB < MALL; v2u cA[5], cB[5];
#pragma unroll
      for (int j = 0; j < 5; ++j) { cA[j] = nA[j]; cB[j] = nB[j]; }
      if (rA + 2 * NGW < MALL) ld_row(rA + 2 * NGW, nA); if (rB + 2 * NGW < MALL) ld_row(rB + 2 * NGW, nB);
#pragma unroll 1
      for (int h = 0; h < 2; ++h) { if (h == 1 && !hasB) break;
        const int row = h ? rB : rA;
        f32x4 v[5];
#pragma unroll
        for (int j = 0; j < 5; ++j) v[j] = bfx4(h ? cB[j] : cA[j]);
        float sq = 0.f;
#pragma unroll
        for (int j = 0; j < 3; ++j) sq += (v[j][0] * v[j][0] + v[j][1] * v[j][1]) + (v[j][2] * v[j][2] + v[j][3] * v[j][3]);
        float sk = (v[3][0] * v[3][0] + v[3][1] * v[3][1]) + (v[3][2] * v[3][2] + v[3][3] * v[3][3]);
        const float rq = 1.f / sqrtf(wave_sum(sq) * (1.f / 768.f) + NORM_EPS), rk = 1.f / sqrtf(wave_sum(sk) * (1.f / 256.f) + NORM_EPS);
        bf16_t* qn = FW(WS_S + S_QN, bf16_t) + (size_t)row * 768 + 4 * F.lane;
#pragma unroll
        for (int j = 0; j < 3; ++j) { const f32x4 h = v[j] * rq * *(const f32x4*)(qg + 4 * F.lane + 256 * j); v2u w; w.x = pk2(h[0], h[1]); w.y = pk2(h[2], h[3]); *(v2u*)(qn + 256 * j) = w; }
        { const f32x4 h = v[3] * rk * *(const f32x4*)(kg + 4 * F.lane); v2u w; w.x = pk2(h[0], h[1]); w.y = pk2(h[2], h[3]); *(v2u*)(FW(WS_S + S_CKVN, bf16_t) + (size_t)row * 256 + 4 * F.lane) = w; }
        f32x4 other;
#pragma unroll
        for (int i = 0; i < 4; ++i) other[i] = __shfl_xor(v[4][i], 4);
        float kn2 = 0.f;
        if (F.lane < 8) { const int b = row / NTB, t = row - b * NTB; f32x4 o = v[4];
            if (t >= CTXL) { const int pos = t - CTXL, gr = pos >> 6, gc = pos & 63; const int l4 = F.lane & 3;
                const int ti = (l4 < 2 ? gr : 128 + gc) * 8 + 4 * (l4 & 1);
                const f32x4 cs = *(const f32x4*)(tab + TAB_COS32 + ti), sn = *(const f32x4*)(tab + TAB_SIN32 + ti);
                o = (F.lane < 4) ? (v[4] * cs - other * sn) : (v[4] * cs + other * sn); }
            v2u w; w.x = pk2(o[0], o[1]); w.y = pk2(o[2], o[3]); *(v2u*)(FW(WS_S + S_KR, bf16_t) + (size_t)row * 32 + 4 * F.lane) = w;
            kn2 = (o[0] * o[0] + o[1] * o[1]) + (o[2] * o[2] + o[3] * o[3]); }
        kn2 += __shfl_xor(kn2, 1); kn2 += __shfl_xor(kn2, 2); kn2 += __shfl_xor(kn2, 4);
        { const int bb = row / NTB; if (bb != kr_b) { if (kr_b >= 0 && F.lane == 0) atomicMax(krmax + kr_b, __float_as_uint(kr_mx)); kr_b = bb; kr_mx = 0.f; } kr_mx = fmaxf(kr_mx, kn2); }
      }
    }
    if (kr_b >= 0 && F.lane == 0) atomicMax(krmax + kr_b, __float_as_uint(kr_mx));
}

constexpr float SCALE64 = 0.125f, SCALE96 = 0.10206207261596577f;
constexpr float ATT_THRL = 16.f;
#define ATT_DISPATCH(DQK, DV, P, NT, TMAP, MASK, E, k2max, bb, flags) do { \
        const bool okw_ = att::rows_bounded<DQK>(P, (k2max), att::ATT_LIM - (bb)); \
        if (F.lane == 0) (flags)[F.tid >> 6] = okw_ ? 1.f : 0.f; \
        __syncthreads(); \
        float all_ = 1.f; _Pragma("unroll") for (int w_ = 0; w_ < 8; ++w_) all_ = fminf(all_, (flags)[w_]); \
        __syncthreads(); \
        if (all_ > 0.5f) att::body<true, DQK, DV>(P, NT, TMAP, MASK, E, ATT_THRL, (char*)F.ldsg + RING_OFF); \
        else att::body<false, DQK, DV>(P, NT, TMAP, MASK, E, ATT_THRL, (char*)F.ldsg + RING_OFF); } while (0)
struct EpiO64 {
    bf16_t* O; int ldo;
    __device__ __forceinline__ void operator()(const f32x16* o, const float* rli, int wid, int r32, int hi) const {
        asm volatile("" : "+v"(r32), "+v"(hi));
        bf16_t* Ow = O + (size_t)(wid * 32) * ldo + r32;
#pragma unroll
        for (int r = 0; r < 16; ++r) { const int orow = att::crow(r, hi);
#pragma unroll
            for (int d0 = 0; d0 < 2; ++d0) Ow[(size_t)orow * ldo + d0 * 32] = (bf16_t)f2bf(o[d0][r] * rli[r]); }
    }
};
struct EpiDA {
    float* T; bf16_t* O; const float* subln; float lam; int pass;
    __device__ __forceinline__ void operator()(const f32x16* o, const float* rli, int wid, int r32, int hi) const {
        asm volatile("" : "+v"(r32), "+v"(hi));
        float* Tw = T + (size_t)(wid * 32) * DM + r32;
        if (pass == 0) {
#pragma unroll
            for (int r = 0; r < 16; ++r) { const int orow = att::crow(r, hi);
#pragma unroll
                for (int d0 = 0; d0 < 4; ++d0) Tw[(size_t)orow * DM + d0 * 32] = o[d0][r] * rli[r]; }
        } else {
            bf16_t* Ow = O + (size_t)(wid * 32) * DM + r32;
            float g[4];
#pragma unroll
            for (int d0 = 0; d0 < 4; ++d0) g[d0] = subln[d0 * 32 + r32] * 0.8f;
#pragma unroll
            for (int r = 0; r < 16; ++r) { const int orow = att::crow(r, hi); float v[4]; float ss = 0.f;
#pragma unroll
                for (int d0 = 0; d0 < 4; ++d0) { v[d0] = Tw[(size_t)orow * DM + d0 * 32] - lam * (o[d0][r] * rli[r]); ss += v[d0] * v[d0]; }
#pragma unroll
                for (int s = 1; s < 32; s <<= 1) ss += __shfl_xor(ss, s);
                const float rs = 1.f / sqrtf(ss * (1.f / 128.f) + NORM_EPS);
#pragma unroll
                for (int d0 = 0; d0 < 4; ++d0) Ow[(size_t)orow * DM + d0 * 32] = (bf16_t)f2bf(v[d0] * rs * g[d0]);
                if (r & 1) asm volatile("" ::: "memory"); }
        }
    }
};
__device__ __forceinline__ void p_att_da(Frame& F0, const Args& A_) {
    Frame F = F0; { int t_ = (int)threadIdx.x; asm volatile("" : "+v"(t_)); F.tid = t_; F.lane = t_ & 63; }
    const bf16_t* Q = FW(WS_S + S_Q, bf16_t); const bf16_t* K = FW(WS_S + S_K, bf16_t); const bf16_t* V = FW(WS_S + S_V, bf16_t);
    bf16_t* O = FW(WS_S + S_O, bf16_t); float* T = FW(WS_S + S_OTMP, float);
    const float lam = FW(WS_TAB, float)[TAB_LAM];
#pragma unroll 1
    for (int it = 2 * F.vcu; it < 2 * 1056; it += ((it & 1) ? 2 * F.G - 1 : 1)) {
        const int U = it >> 1, pass = it & 1;
        int bh, qb; if (U < 1024) { bh = U >> 5; qb = 1 + (U & 31); } else { bh = U - 1024; qb = 0; }
        const int b = bh >> 3, h = bh & 7; const size_t row0 = (size_t)b * NTB + qb * 256, krow0 = (size_t)b * NTB;
        const int sub = 2 * h + pass;
        att::Ptrs P; P.q1 = Q + row0 * DM + sub * 64; P.q2 = nullptr; P.ldq1 = DM; P.ldq2 = 0; P.k1 = K + krow0 * DM + sub * 64; P.k2 = nullptr; P.ldk1 = DM; P.ldk2 = 0; P.v = V + krow0 * DM + h * 128; P.ldv = DM;
        EpiDA E{T + row0 * DM + h * 128, O + row0 * DM + h * 128, AIN(15), lam, pass};
        const float* km = (const float*)(F.ws + WS_CTL) + CW_KMAX + (b * 16 + sub) * 2; const float k2max = km[0] + km[1];
        float* flags = (float*)((char*)F.ldsg + RING_OFF + att::Cfg<64, 128>::OFF_AUX) + 512;
        ATT_DISPATCH(64, 128, P, qb == 0 ? 4 : 132, att::DenseMap{}, att::NoMask{}, E, k2max, 0.f, flags);
    }
}
__device__ __forceinline__ void p_att_mla(Frame& F0) {
    Frame F = F0; { int t_ = (int)threadIdx.x; asm volatile("" : "+v"(t_)); F.tid = t_; F.lane = t_ & 63; }
    const bf16_t* QN = FW(WS_S + S_MQ, bf16_t); const bf16_t* QR = FW(WS_S + S_MQ + 66 * MiB, bf16_t);
    const bf16_t* KN = FW(WS_S + S_MKN, bf16_t); const bf16_t* KR = FW(WS_S + S_KR, bf16_t); const bf16_t* V = FW(WS_S + S_MV, bf16_t); bf16_t* O = FW(WS_S + S_MO, bf16_t);
    for (int U = F.vcu; U < 2048; U += F.G) {
        const int bh = U >> 5, qb = 1 + (U & 31);
        const int b = bh >> 4, h = bh & 15; const size_t row0 = (size_t)b * NTB + qb * 256, krow0 = (size_t)b * NTB;
        att::Ptrs P; P.q1 = QN + row0 * DM + h * 64; P.ldq1 = DM; P.q2 = QR + row0 * 512 + h * 32; P.ldq2 = 512;
        P.k1 = KN + krow0 * DM + h * 64; P.ldk1 = DM; P.k2 = KR + krow0 * 32; P.ldk2 = 32; P.v = V + krow0 * DM + h * 64; P.ldv = DM;
        EpiO64 E{O + row0 * DM + h * 64, DM};
        const float* km = (const float*)(F.ws + WS_CTL) + CW_KMAX; const float k2max = km[256 + (b * 16 + h) * 2] + km[256 + (b * 16 + h) * 2 + 1] + km[384 + b];
        float* flags = (float*)((char*)F.ldsg + RING_OFF + att::Cfg<96, 64>::OFF_AUX) + 512;
        ATT_DISPATCH(96, 64, P, 132, att::DenseMap{}, att::NoMask{}, E, k2max, 0.f, flags);
    }
}
struct NaMap { int kr0, nlat; __device__ __forceinline__ long operator()(int j) const { if (j < 4) return (long)j * 64; int t = j - 4; t = t < nlat ? t : nlat - 1; return (long)CTXL + 64L * (kr0 + t); } };
struct NaMask { int kr0, nlat, rq, r0q, qc, c0, hi; const float* bias; bool on;
    __device__ __forceinline__ void operator()(f32x16& p0, f32x16& p1, int j) const {
        if (!on || j < 4) return;
        const int t = j - 4, kr = kr0 + t; const bool vrow = (t < nlat) && (kr >= r0q) && (kr < r0q + 8);
        const float* brow = bias + (kr - rq + 7) * 31 - qc + 15;
#pragma unroll
        for (int r = 0; r < 16; ++r) { const int kc = att::crow(r, hi);
            { const bool v = vrow && (kc >= c0) && (kc < c0 + 16); p0[r] = v ? p0[r] + brow[v ? kc : qc] : -1e30f; }
            { const int kc2 = kc + 32; const bool v = vrow && (kc2 >= c0) && (kc2 < c0 + 16); p1[r] = v ? p1[r] + brow[v ? kc2 : qc] : -1e30f; } }
    }
};
__device__ __forceinline__ void p_att_na(Frame& F0, const Args& A_) {
    Frame F = F0; { int t_ = (int)threadIdx.x; asm volatile("" : "+v"(t_)); F.tid = t_; F.lane = t_ & 63; }
    const bf16_t* Q = FW(WS_S + S_Q, bf16_t); const bf16_t* K = FW(WS_S + S_K, bf16_t); const bf16_t* V = FW(WS_S + S_V, bf16_t); bf16_t* O = FW(WS_S + S_O, bf16_t);
    constexpr int NABT_OFF = 57344; static_assert(att::Cfg<64, 64>::BYTES <= NABT_OFF && NABT_OFF + 16 * 512 * 4 <= RING_BYTES, "bias tables");
    float* btab_all = (float*)((char*)F.ldsg + RING_OFF + NABT_OFF); float* flags = (float*)((char*)F.ldsg + RING_OFF + att::Cfg<64, 64>::OFF_AUX) + 512;
    __syncthreads();
    for (int i = F.tid; i < 16 * 465; i += NTHR) { const int hh = i / 465, ii = i - hh * 465; btab_all[hh * 512 + ii] = AIN(19)[i] * LOG2E; }
    for (int hh = 2 * (F.tid >> 6); hh < 2 * (F.tid >> 6) + 2; ++hh) { float bmx = 0.f;
        for (int ii = F.lane; ii < 465; ii += 64) bmx = fmaxf(bmx, fabsf(AIN(19)[hh * 465 + ii] * LOG2E));
#pragma unroll
        for (int o = 1; o < 64; o <<= 1) bmx = fmaxf(bmx, __shfl_xor(bmx, o));
        if (F.lane == 0) btab_all[hh * 512 + 480] = bmx; }
    __syncthreads();
    for (int U = F.vcu; U < 2112; U += F.G) {
        int bh, qb; const bool lat = U < 2048; if (lat) { bh = U >> 5; qb = U & 31; } else { bh = U - 2048; qb = 0; }
        const int b = bh >> 4, h = bh & 15; const size_t row0 = (size_t)b * NTB + (lat ? CTXL + qb * 256 : 0), krow0 = (size_t)b * NTB;
        float* btab = btab_all + h * 512;
        const int R = 4 * qb; int lo = R - 4; lo = lo < 0 ? 0 : (lo > 120 ? 120 : lo); int hi2 = R - 1; hi2 = hi2 < 0 ? 0 : (hi2 > 120 ? 120 : hi2);
        const int nlat = lat ? (hi2 + 7 - lo + 1) : 0; const int NT = lat ? ((4 + nlat + 1) & ~1) : 4;
        const int wid = F.tid >> 6, r32 = F.lane & 31;
        const int rq = R + (wid >> 1), qc = (wid & 1) * 32 + r32; int r0q = rq - 4; r0q = r0q < 0 ? 0 : (r0q > 120 ? 120 : r0q); int c0 = qc - 8; c0 = c0 < 0 ? 0 : (c0 > 48 ? 48 : c0);
        att::Ptrs P; P.q1 = Q + row0 * DM + h * 64; P.q2 = nullptr; P.ldq1 = DM; P.ldq2 = 0; P.k1 = K + krow0 * DM + h * 64; P.k2 = nullptr; P.ldk1 = DM; P.ldk2 = 0; P.v = V + krow0 * DM + h * 64; P.ldv = DM;
        EpiO64 E{O + row0 * DM + h * 64, DM};
        const float* km = (const float*)(F.ws + WS_CTL) + CW_KMAX + 128 + (b * 16 + h) * 2; const float k2max = km[0] + km[1];
        const float bb = btab[480];
        ATT_DISPATCH(64, 64, P, NT, (NaMap{lo, lat ? nlat : 1}), (NaMask{lo, nlat, rq, r0q, qc, c0, F.lane >> 5, btab, lat}), E, k2max, bb, flags);
    }
}

__device__ __forceinline__ pg8::Order make_order(int nM, int nN, int nZ, int G, int c) { pg8::Order S; S.init(nM, nN, nZ, G, c); return S; }
constexpr int NPH = 36;
#ifndef MK_ONLY
#define MK_ONLY -1
#endif
#define SITE(id) (MK_ONLY < 0 || MK_ONLY == (id))
#ifndef MK_REPEAT
#define MK_REPEAT -1
#endif
__device__ __forceinline__ int nrep_(int id) { if (MK_REPEAT != id) return 1; int n = 2; asm volatile("" : "+s"(n)); return n; }
constexpr bool mix_on(int l) { return MK_NSTAGE > 2 * l; }
constexpr bool moe_on(int l) { return MK_NSTAGE > 2 * l + 1; }
#define IN(k) (lo <= (k) && (k) < hi)
#define SEAM(k) do { if (MK_ONE_LAUNCH && IN(k) && IN((k) + 1)) xcd_barrier(bar); } while (0)
#define mk_order(nM, nN, nZ) make_order((nM), (nN), (nZ), F.G, (int)blockIdx.x)
template <int l> __device__ __forceinline__ void layer_body(Frame& F, const Args& A_, const XcdBarrier& bar, const int lo, const int hi) {
    LAS unsigned char* ring = F.lds + RING_OFF; xres_t* X = FW(WS_X, xres_t); bf16_t* H = FW(WS_H, bf16_t);
        const int nb = (l == 0) ? 1 : (l == 1) ? 9 : (l == 2) ? 17 : 25;
        const int pb = (l == 0) ? 5 : (l == 1) ? 13 : (l == 2) ? 21 : 31;
        const bool mix = MK_NSTAGE > 2 * l, moe = MK_NSTAGE > 2 * l + 1, moe_prev = (l > 0) && (MK_NSTAGE > 2 * l - 1);
        if (IN(nb) && SITE(1)) { for (int rep_ = 0; rep_ < nrep_(1); ++rep_) { p_norm1(F, l, moe_prev, A_); if (l == 1 && mix && SITE(2)) p_dftgen(F); } } SEAM(nb);
        if constexpr (l == 0) {
            if (IN(2) && mix && SITE(3)) { for (int rep_ = 0; rep_ < nrep_(3); ++rep_) { pg8::Gemm g{H, FW(W_DA_QKV, bf16_t), DM, DM, DM, 0, 0, nullptr, 0};
                pg8::EpiQKVRope E{(unsigned*)(F.ws + WS_CTL) + CW_KMAX, FW(WS_S + S_Q, bf16_t), (size_t)(S_K - S_Q) / 2, FW(WS_TAB, float), SCALE64 * LOG2E};
                pg8::gemm_phase<pg8::EpiQKVRope, false>(ring, g, mk_order(132, 12, 1), E); } } SEAM(2);
            if (IN(3) && mix && SITE(4)) { for (int rep_ = 0; rep_ < nrep_(4); ++rep_) { p_att_da(F, A_); } } SEAM(3);
            if (IN(4) && mix && SITE(5)) { for (int rep_ = 0; rep_ < nrep_(5); ++rep_) { pg8::Gemm g{FW(WS_S + S_O, bf16_t), FW(W_DA_O, bf16_t), DM, DM, DM, 0, 0, nullptr, 0};
                pg8::EpiResid E{rep_ ? FW(WS_Y, xres_t) : X, mod_ptr(F, 0) + 2 * 1024, 0, 0};
                pg8::gemm_phase<pg8::EpiResid, false>(ring, g, mk_order(132, 4, 1), E); } } SEAM(4);
        } else if constexpr (l == 1) {
            if (IN(10) && mix && SITE(6)) { for (int rep_ = 0; rep_ < nrep_(6); ++rep_) { pg8::Gemm g{FW(W_FN, bf16_t), H, DM, DM, DM, 0, 0, nullptr, 0};
                pg8::EpiFnT E{FW(WS_S + S_TT, bf16_t), FW(WS_S + S_TTC, bf16_t)};
                pg8::gemm_phase<pg8::EpiFnT, false, 1>(ring, g, mk_order(8, 33, 4), E); } } SEAM(10);
            if (IN(11) && mix && SITE(7)) { for (int rep_ = 0; rep_ < nrep_(7); ++rep_) { pg8::Gemm g{FW(WS_S + S_W2, bf16_t), FW(WS_S + S_TT, bf16_t), 256, 256, 256, 0, 0, nullptr, 0};
                pg8::EpiFA E{FW(WS_S + S_G2, bf16_t)};
                pg8::gemm_phase<pg8::EpiFA, false>(ring, g, mk_order(1, 1024, 1), E); } } SEAM(11);
            if (IN(12) && mix && SITE(21)) { for (int rep_ = 0; rep_ < nrep_(21); ++rep_) { pg8::Gemm g{FW(WS_S + S_W1B, bf16_t), FW(WS_S + S_G2, bf16_t), 512, 16384, 512, 0, 0, nullptr, 0};
                pg8::EpiFC E{X, mod_ptr(F, 1) + 2 * 1024};
                pg8::gemm_phase<pg8::EpiFC, false, 2>(ring, g, mk_order(1, 4, 128), E); } }
            if (IN(12) && mix && SITE(22)) { for (int rep_ = 0; rep_ < nrep_(22); ++rep_) { pg8::Gemm g{FW(WS_S + S_DFTC, bf16_t), FW(WS_S + S_TTC, bf16_t), 512, 4 * 512, 512, 0, 512, nullptr, 0};
                pg8::EpiResid E{rep_ ? FW(WS_Y, xres_t) : X, mod_ptr(F, 1) + 2 * 1024, NTB, 0};
                pg8::gemm_phase<pg8::EpiResid, false>(ring, g, mk_order(1, 4, 4), E); } } SEAM(12);
        } else if constexpr (l == 2) {
            if (IN(18) && mix && SITE(8)) { for (int rep_ = 0; rep_ < nrep_(8); ++rep_) { pg8::Gemm g{H, FW(W_NA_QKV, bf16_t), DM, DM, DM, 0, 0, nullptr, 0};
                pg8::EpiBf16Split E{FW(WS_S + S_Q, bf16_t), (size_t)(S_K - S_Q) / 2, SCALE64 * LOG2E, (unsigned*)(F.ws + WS_CTL) + CW_KMAX + 128, 1};
                pg8::gemm_phase<pg8::EpiBf16Split, false>(ring, g, mk_order(132, 12, 1), E); } } SEAM(18);
            if (IN(19) && mix && SITE(9)) { for (int rep_ = 0; rep_ < nrep_(9); ++rep_) { p_att_na(F, A_); } } SEAM(19);
            if (IN(20) && mix && SITE(10)) { for (int rep_ = 0; rep_ < nrep_(10); ++rep_) { pg8::Gemm g{FW(WS_S + S_O, bf16_t), FW(W_NA_O, bf16_t), DM, DM, DM, 0, 0, nullptr, 0};
                pg8::EpiResid E{rep_ ? FW(WS_Y, xres_t) : X, mod_ptr(F, 2) + 2 * 1024, 0, 0};
                pg8::gemm_phase<pg8::EpiResid, false>(ring, g, mk_order(132, 4, 1), E); } } SEAM(20);
        } else {
            if (IN(26) && mix && SITE(11)) { for (int rep_ = 0; rep_ < nrep_(11); ++rep_) { pg8::Gemm g{H, FW(W_MLA_DQKV, bf16_t), DM, DM, DM, 0, 0, nullptr, 0};
                pg8::EpiBf16 E{FW(WS_S + S_DQ, bf16_t), 1280, 0};
                pg8::gemm_phase<pg8::EpiBf16, false>(ring, g, mk_order(132, 5, 1), E); } } SEAM(26);
            if (IN(27) && mix && SITE(12)) { for (int rep_ = 0; rep_ < nrep_(12); ++rep_) { p_mla_norm(F, A_); } } SEAM(27);
            if (IN(28) && mix && SITE(13)) { for (int rep_ = 0; rep_ < nrep_(13); ++rep_) { pg8::Gemm g{FW(WS_S + S_QN, bf16_t), FW(W_MLA_UQ, bf16_t), 768, 768, 768, 0, 0, nullptr, 0};
                pg8::EpiMlaQ E{FW(WS_S + S_MQ, bf16_t), FW(WS_S + S_MQ + 66 * MiB, bf16_t), FW(WS_TAB, float), SCALE96 * LOG2E};
                pg8::gemm_phase<pg8::EpiMlaQ, false>(ring, g, mk_order(132, 6, 1), E); } }
            if (IN(28) && mix && SITE(23)) { for (int rep_ = 0; rep_ < nrep_(23); ++rep_) { pg8::Gemm g{FW(WS_S + S_CKVN, bf16_t), FW(W_MLA_UKV, bf16_t), 256, 256, 256, 0, 0, nullptr, 0};
                pg8::EpiBf16Split E{FW(WS_S + S_MKN, bf16_t), (size_t)(S_MV - S_MKN) / 2, 1.f, (unsigned*)(F.ws + WS_CTL) + CW_KMAX + 256, 0};
                pg8::gemm_phase<pg8::EpiBf16Split, false>(ring, g, mk_order(132, 8, 1), E); } } SEAM(28);
            if (IN(29) && mix && SITE(14)) { for (int rep_ = 0; rep_ < nrep_(14); ++rep_) { p_att_mla(F); } } SEAM(29);
            if (IN(30) && mix && SITE(15)) { for (int rep_ = 0; rep_ < nrep_(15); ++rep_) { pg8::Gemm g{FW(WS_S + S_MO, bf16_t) + (size_t)CTXL * DM, FW(W_MLA_O, bf16_t), DM, DM, DM, (long)NTB * DM, 0, nullptr, 0};
                pg8::EpiResid E{rep_ ? FW(WS_Y, xres_t) : X, mod_ptr(F, 3) + 2 * 1024, NTB, CTXL};
                pg8::gemm_phase<pg8::EpiResid, false>(ring, g, mk_order(32, 4, 4), E); } } SEAM(30);
        }
        if (IN(pb) && moe && SITE(16)) { for (int rep_ = 0; rep_ < nrep_(16); ++rep_) { p_norm2_router(F, l, l == DEPTH - 1, A_); } } SEAM(pb);
        if (IN(pb + 1) && moe && SITE(17)) { for (int rep_ = 0; rep_ < nrep_(17); ++rep_) { p_topk(F, l == DEPTH - 1 ? 64 : 128); } } SEAM(pb + 1);
        if (IN(pb + 2) && moe && SITE(18)) { for (int rep_ = 0; rep_ < nrep_(18); ++rep_) { pg8::Gemm g{H, FW(WS_WGU, bf16_t) + (size_t)l * NEXP * 4096 * 1024, DM, DM, DM, 0, (long)4096 * 1024, FW(WS_IDX, int), SLOTS_E};
            pg8::EpiGateUp E{FW(WS_S + S_ACT, bf16_t)};
            pg8::gemm_phase<pg8::EpiGateUp, true>(ring, g, mk_order(l == DEPTH - 1 ? 16 : 17, 16, NEXP), E); } } SEAM(pb + 2);
        if (IN(pb + 3) && moe && SITE(19)) { for (int rep_ = 0; rep_ < nrep_(19); ++rep_) { pg8::Gemm g{FW(WS_S + S_ACT, bf16_t), FW(WS_WDN, bf16_t) + (size_t)l * NEXP * 1024 * 2048, EDIM, EDIM, EDIM, (long)SLOTS_E * EDIM, (long)1024 * 2048, nullptr, 0};
            pg8::EpiDown E{FW(WS_Y, bf16_t), FW(WS_GATE, float)};
            pg8::gemm_phase<pg8::EpiDown, false>(ring, g, mk_order(16, 4, NEXP), E); } }
        if (IN(pb + 3) && moe && l < DEPTH - 1 && SITE(24)) { for (int rep_ = 0; rep_ < nrep_(24); ++rep_) {
            pg8::Gemm g{FW(WS_S + S_ACT, bf16_t) + (size_t)4096 * EDIM, FW(WS_WDN, bf16_t) + (size_t)l * NEXP * 1024 * 2048, EDIM, EDIM, 512, (long)SLOTS_E * EDIM, (long)1024 * 2048, nullptr, 0};
            pg8::EpiDownCtx E{FW(WS_YC, float), FW(WS_GATE, float)};
            pg8::gemm_phase<pg8::EpiDownCtx, false, 3>(ring, g, mk_order(1, 4, NEXP * 4), E); } } SEAM(pb + 3);
    }
__global__ void __launch_bounds__(NTHR, 2) trunk_fwd(Args args) {
    extern __shared__ __attribute__((aligned(16))) unsigned char lds[];
    Frame F;
    F.lds = (LAS unsigned char*)lds; F.ldsg = lds;
    F.MISC = (volatile LAS unsigned*)(F.lds + MISC_OFF);
    F.tid = threadIdx.x; F.lane = F.tid & 63; F.wave = __builtin_amdgcn_readfirstlane(F.tid >> 6);
    F.G = gridDim.x; { const int bx = blockIdx.x; F.vcu = (F.G % 8 == 0) ? (bx % 8) * (F.G / 8) + bx / 8 : bx; }
    F.ws = args.ws; F.out = args.out;
    const Args& A_ = args;
    for (int u = F.tid; u < (LDS_BYTES - LDSCTL_OFF) / 4; u += NTHR) ((LAS unsigned*)(F.lds + LDSCTL_OFF))[u] = 0u;
    __syncthreads();
    XcdBarrier bar; bar.bar = (unsigned*)(F.ws + WS_CTL) + CW_BAR; bar.x = 0; bar.st = nullptr;
    if (MK_ONE_LAUNCH) bar = xcd_barrier_post((unsigned*)(F.ws + WS_CTL) + CW_BAR, F.MISC + 8);
    const int lo = args.ph_lo, hi = args.ph_hi;
    LAS unsigned char* ring = F.lds + RING_OFF;
    xres_t* X = FW(WS_X, xres_t); bf16_t* H = FW(WS_H, bf16_t);

    if (IN(0) && SITE(0)) { for (int rep_ = 0; rep_ < nrep_(0); ++rep_) { p_prologue(F, A_); } } SEAM(0);
    layer_body<0>(F, A_, bar, lo, hi); layer_body<1>(F, A_, bar, lo, hi); layer_body<2>(F, A_, bar, lo, hi); layer_body<3>(F, A_, bar, lo, hi);
    if (IN(35) && SITE(20)) { for (int rep_ = 0; rep_ < nrep_(20); ++rep_) { p_final(F, moe_on(3), A_); } }
}

extern "C" void kernel_launch(void* const* d_in, const int* in_sizes, int n_in, void* d_out, int out_size, void* d_ws, size_t ws_size, hipStream_t stream) {
    static int grid = 0;
    if (grid == 0) {
        if (n_in != 32 || out_size != NB * SEQ * DM || ws_size < WS_END) { fprintf(stderr, "kernel_launch: unexpected shapes: n_in %d out %d ws %zu (need %zu)\n", n_in, out_size, ws_size, (size_t)WS_END); grid = -1; return; }
        int dev = 0, cus = 0, per_cu = 0;
        if (hipGetDevice(&dev) != hipSuccess || hipDeviceGetAttribute(&cus, hipDeviceAttributeMultiprocessorCount, dev) != hipSuccess) { grid = -1; return; }
        if (hipFuncSetAttribute((const void*)trunk_fwd, hipFuncAttributeMaxDynamicSharedMemorySize, LDS_BYTES) != hipSuccess) { fprintf(stderr, "kernel_launch: hipFuncSetAttribute failed\n"); grid = -1; return; }
        if (hipOccupancyMaxActiveBlocksPerMultiprocessor(&per_cu, (const void*)trunk_fwd, NTHR, LDS_BYTES) != hipSuccess || per_cu < 1)
            fprintf(stderr, "kernel_launch: note: occupancy query reports %d workgroups per CU\n", per_cu);
        (void)hipGetLastError();
        grid = cus;
    }
    if (grid < 0) return;
    (void)hipMemsetAsync((char*)d_ws + WS_CTL, 0, CTL_ZERO_BYTES, stream);
    Args a{};
    for (int i = 0; i < 32; ++i) a.in[i] = (const float*)d_in[i];
    a.out = (float*)d_out; a.ws = (unsigned char*)d_ws;
#if MK_ONE_LAUNCH
    a.ph_lo = 0; a.ph_hi = NPH;
    hipLaunchKernelGGL(trunk_fwd, dim3(grid), dim3(NTHR), LDS_BYTES, stream, a);
#else
    for (int ph = 0; ph < NPH; ++ph) { a.ph_lo = ph; a.ph_hi = ph + 1; hipLaunchKernelGGL(trunk_fwd, dim3(grid), dim3(NTHR), LDS_BYTES, stream, a); }
#endif
    const hipError_t le = hipPeekAtLastError();
    if (le != hipSuccess) fprintf(stderr, "kernel_launch: launch failed: %s\n", hipGetErrorName(le));
}
```
